# Optimizing an MI355X kernel written in HIP

```python
import math
import jax, jax.numpy as jnp
from jax import lax
import numpy as np

D_MODEL = 1024
BATCH = 1
SEQ = 16384
DEPTH = 4

N_MIXERS = 3
ALPHA = (2.0 * DEPTH) ** 0.25
BETA = (8.0 * DEPTH) ** -0.25
LN_EPS = 1e-5
HEAD_NORM_EPS = 1e-6

HGRN_EXPAND = 128
HGRN_HEADS = D_MODEL // HGRN_EXPAND
HGRN_DK = HGRN_EXPAND
HGRN_DV = D_MODEL // HGRN_HEADS
HGRN_CHUNK = 64

MLSTM_HEADS = 8
MLSTM_DV = D_MODEL // MLSTM_HEADS
MLSTM_DQK = MLSTM_DV // 2
MLSTM_CONV = 4
MLSTM_CHUNK = 64
MLSTM_QK_W = MLSTM_HEADS * MLSTM_DQK
MLSTM_IN_W = 2 * MLSTM_QK_W + 2 * D_MODEL + 2 * MLSTM_HEADS

S5_GROUP_CH = 16
S5_GROUPS = D_MODEL // S5_GROUP_CH
S5_STATE = 64
S5_CHUNK = 1024
S5_DT_MIN = 1e-3
S5_DT_MAX = 1e-1

FFN_HIDDEN = -(-8 * D_MODEL // (3 * 256)) * 256

N_HGRN = (DEPTH + 2) // 3
N_MLSTM = (DEPTH + 1) // 3
N_S5 = DEPTH // 3

kernel_name = "hybrid_hgrn2_mlstm_s5_deepnorm"


def _layernorm(x, g, b):
    xf = x.astype(jnp.float32)
    mu = jnp.mean(xf, axis=-1, keepdims=True)
    xc = xf - mu
    var = jnp.mean(xc * xc, axis=-1, keepdims=True)
    return (xc * lax.rsqrt(var + LN_EPS) * g + b).astype(x.dtype)


def _head_rmsnorm(h, w):
    return h * lax.rsqrt(jnp.mean(h * h, axis=-1, keepdims=True) + HEAD_NORM_EPS) * w


def _to_chunks(t, n_heads, chunk):
    bsz, seq, width = t.shape
    return t.reshape(bsz, seq // chunk, chunk, n_heads, width // n_heads).transpose(1, 0, 3, 2, 4)


def _from_chunks(t):
    nc, bsz, h, c, d = t.shape
    return t.transpose(1, 0, 3, 2, 4).reshape(bsz, nc * c, h, d)


def _causal_conv(u, w):
    k_w = w.shape[0]
    seq = u.shape[1]
    up = jnp.pad(u, ((0, 0), (k_w - 1, 0), (0, 0)))
    out = up[:, 0:seq] * w[0]
    for j in range(1, k_w):
        out = out + up[:, j:j + seq] * w[j]
    return out


def _hgrn_lower_bounds(lb_logits):
    p = jax.nn.softmax(lb_logits.astype(jnp.float32), axis=0)
    c = jnp.cumsum(p, axis=0)
    return c - c[0:1]


def _hgrn2_mixer(x, w_in, norm_w, w_out, lb):
    bsz, seq, _ = x.shape
    q, f, v, g = jnp.split(x @ w_in, 4, axis=-1)
    f = f.astype(jnp.float32)
    log_f = jnp.logaddexp(jnp.log(lb), jnp.log1p(-lb) + jax.nn.log_sigmoid(f))
    k = (1.0 - lb) * jax.nn.sigmoid(-f)
    q = jax.nn.silu(q.astype(jnp.float32))
    qc = _to_chunks(q, HGRN_HEADS, HGRN_CHUNK)
    kc = _to_chunks(k, HGRN_HEADS, HGRN_CHUNK)
    vc = _to_chunks(v.astype(jnp.float32), HGRN_HEADS, HGRN_CHUNK)
    lfc = _to_chunks(log_f, HGRN_HEADS, HGRN_CHUNK)
    mask = jnp.tril(jnp.ones((HGRN_CHUNK, HGRN_CHUNK), dtype=bool))

    def step(s_prev, inp):
        qb, kb, vb, lfb = inp
        b = jnp.cumsum(lfb, axis=2)
        diff = b[:, :, :, None, :] - b[:, :, None, :, :]
        decay = jnp.exp(jnp.where(mask[:, :, None], diff, -jnp.inf))
        att = jnp.einsum('bhtd,bhsd,bhtsd->bhts', qb, kb, decay)
        o = jnp.einsum('bhts,bhse->bhte', att, vb) + jnp.einsum('bhtd,bhde->bhte', qb * jnp.exp(b), s_prev)
        b_last = b[:, :, -1]
        k_dec = kb * jnp.exp(b_last[:, :, None, :] - b)
        s_new = jnp.exp(b_last)[..., None] * s_prev + jnp.einsum('bhsd,bhse->bhde', k_dec, vb)
        return s_new, o

    s0 = jnp.zeros((bsz, HGRN_HEADS, HGRN_DK, HGRN_DV), jnp.float32)
    _, oc = lax.scan(step, s0, (qc, kc, vc, lfc))
    o = _head_rmsnorm(_from_chunks(oc), norm_w.astype(jnp.float32))
    o = o.reshape(bsz, seq, D_MODEL) * jax.nn.silu(g.astype(jnp.float32))
    return o.astype(x.dtype) @ w_out


def _mlstm_mixer(x, w_in, conv_w, gate_b, norm_w, w_out):
    bsz, seq, _ = x.shape
    proj = x @ w_in
    qk = proj[..., :2 * MLSTM_QK_W]
    v = proj[..., 2 * MLSTM_QK_W:2 * MLSTM_QK_W + D_MODEL]
    o_pre = proj[..., 2 * MLSTM_QK_W + D_MODEL:2 * MLSTM_QK_W + 2 * D_MODEL]
    gates = proj[..., 2 * MLSTM_QK_W + 2 * D_MODEL:].astype(jnp.float32) + gate_b.astype(jnp.float32)
    qk = jax.nn.silu(_causal_conv(qk, conv_w).astype(jnp.float32))
    q = qk[..., :MLSTM_QK_W]
    k = qk[..., MLSTM_QK_W:] * (MLSTM_DQK ** -0.5)
    log_i = gates[..., :MLSTM_HEADS]
    log_f = jax.nn.log_sigmoid(gates[..., MLSTM_HEADS:])
    qc = _to_chunks(q, MLSTM_HEADS, MLSTM_CHUNK)
    kc = _to_chunks(k, MLSTM_HEADS, MLSTM_CHUNK)
    vc = _to_chunks(v.astype(jnp.float32), MLSTM_HEADS, MLSTM_CHUNK)
    lic = _to_chunks(log_i, MLSTM_HEADS, MLSTM_CHUNK)[..., 0]
    lfc = _to_chunks(log_f, MLSTM_HEADS, MLSTM_CHUNK)[..., 0]
    mask = jnp.tril(jnp.ones((MLSTM_CHUNK, MLSTM_CHUNK), dtype=bool))

    def step(carry, inp):
        c_prev, n_prev, m_prev = carry
        qb, kb, vb, lib, lfb = inp
        b = jnp.cumsum(lfb, axis=-1)
        log_d = jnp.where(mask, b[..., :, None] - b[..., None, :] + lib[..., None, :], -jnp.inf)
        log_inter = b + m_prev[..., None]
        m_t = jnp.maximum(jnp.max(log_d, axis=-1), log_inter)
        d_mat = jnp.exp(log_d - m_t[..., None])
        w_inter = jnp.exp(log_inter - m_t)
        s = jnp.einsum('bhtd,bhsd->bhts', qb, kb) * d_mat
        num = jnp.einsum('bhts,bhse->bhte', s, vb) + w_inter[..., None] * jnp.einsum('bhtd,bhde->bhte', qb, c_prev)
        den = jnp.sum(s, axis=-1) + w_inter * jnp.einsum('bhtd,bhd->bht', qb, n_prev)
        h = num / jnp.maximum(jnp.abs(den), jnp.exp(-m_t))[..., None]
        b_last = b[..., -1]
        log_w = b_last[..., None] - b + lib
        m_new = jnp.maximum(b_last + m_prev, jnp.max(log_w, axis=-1))
        w_s = jnp.exp(log_w - m_new[..., None])
        w_prev = jnp.exp(b_last + m_prev - m_new)
        c_new = w_prev[..., None, None] * c_prev + jnp.einsum('bhs,bhsd,bhse->bhde', w_s, kb, vb)
        n_new = w_prev[..., None] * n_prev + jnp.einsum('bhs,bhsd->bhd', w_s, kb)
        return (c_new, n_new, m_new), h

    init = (jnp.zeros((bsz, MLSTM_HEADS, MLSTM_DQK, MLSTM_DV), jnp.float32),
            jnp.zeros((bsz, MLSTM_HEADS, MLSTM_DQK), jnp.float32),
            jnp.zeros((bsz, MLSTM_HEADS), jnp.float32))
    _, hc = lax.scan(step, init, (qc, kc, vc, lic, lfc))
    h = _head_rmsnorm(_from_chunks(hc), norm_w.astype(jnp.float32).reshape(MLSTM_HEADS, MLSTM_DV))
    h = h.reshape(bsz, seq, D_MODEL) * jax.nn.sigmoid(o_pre.astype(jnp.float32))
    return h.astype(x.dtype) @ w_out


def _cmul(ar, ai, br, bi):
    return ar * br - ai * bi, ar * bi + ai * br


def _s5_combine(e1, e2):
    a1r, a1i, b1r, b1i = e1
    a2r, a2i, b2r, b2i = e2
    ar, ai = _cmul(a2r, a2i, a1r, a1i)
    tr, ti = _cmul(a2r, a2i, b1r, b1i)
    return ar, ai, tr + b2r, ti + b2i


def _s5_mixer(x, w_in, a_re, a_im, log_dt, b_re, b_im, c_re, c_im, d_skip, w_out):
    bsz, seq, _ = x.shape
    f32 = jnp.float32
    u = (x @ w_in).astype(f32)
    a_re = a_re.astype(f32)
    a_im = a_im.astype(f32)
    b_re = b_re.astype(f32)
    b_im = b_im.astype(f32)
    c_re = c_re.astype(f32)
    c_im = c_im.astype(f32)
    dt = jnp.exp(log_dt.astype(f32))[:, None]
    mag = jnp.exp(a_re * dt)
    abar_re = mag * jnp.cos(a_im * dt)
    abar_im = mag * jnp.sin(a_im * dt)
    nr = abar_re - 1.0
    ni = abar_im
    den = a_re * a_re + a_im * a_im
    coef_re = (nr * a_re + ni * a_im) / den
    coef_im = (ni * a_re - nr * a_im) / den
    bbar_re = coef_re[..., None] * b_re - coef_im[..., None] * b_im
    bbar_im = coef_re[..., None] * b_im + coef_im[..., None] * b_re
    chunk = math.gcd(seq, S5_CHUNK)
    nc = seq // chunk
    ug = u.reshape(bsz, nc, chunk, S5_GROUPS, S5_GROUP_CH).transpose(1, 0, 2, 3, 4)
    a_r = jnp.broadcast_to(abar_re, (bsz, chunk, S5_GROUPS, S5_STATE))
    a_i = jnp.broadcast_to(abar_im, (bsz, chunk, S5_GROUPS, S5_STATE))

    def step(carry, ub):
        hr, hi = carry
        bu_re = jnp.einsum('blgc,gpc->blgp', ub, bbar_re)
        bu_im = jnp.einsum('blgc,gpc->blgp', ub, bbar_im)
        pr, pi, sr, si = lax.associative_scan(_s5_combine, (a_r, a_i, bu_re, bu_im), axis=1)
        cr, ci = _cmul(pr, pi, hr[:, None], hi[:, None])
        sr = sr + cr
        si = si + ci
        y = jnp.einsum('blgp,gcp->blgc', sr, c_re) - jnp.einsum('blgp,gcp->blgc', si, c_im)
        return (sr[:, -1], si[:, -1]), y

    h0 = (jnp.zeros((bsz, S5_GROUPS, S5_STATE), f32), jnp.zeros((bsz, S5_GROUPS, S5_STATE), f32))
    _, yc = lax.scan(step, h0, ug)
    y = yc.transpose(1, 0, 2, 3, 4).reshape(bsz, seq, D_MODEL)
    y = y + d_skip.astype(f32) * u
    y = jax.nn.gelu(y).astype(x.dtype)
    za, zb = jnp.split(y @ w_out, 2, axis=-1)
    return za * jax.nn.sigmoid(zb)


def _swiglu(x, w_gate_up, w_down):
    gate, up = jnp.split(x @ w_gate_up, 2, axis=-1)
    return (jax.nn.silu(gate) * up) @ w_down


def setup_inputs(seed: int = 0) -> dict:
    key = jax.random.key(seed)
    ks = jax.random.split(key, 24)
    D = D_MODEL
    nrm = jax.random.normal
    x = nrm(ks[0], (BATCH, SEQ, D), jnp.float32)
    hgrn_w_in = nrm(ks[1], (N_HGRN, D, 4 * D), jnp.float32) * D ** -0.5
    hgrn_norm_w = 1.0 + 0.02 * nrm(ks[2], (N_HGRN, HGRN_DV), jnp.float32)
    hgrn_w_out = nrm(ks[3], (N_HGRN, D, D), jnp.float32) * (D ** -0.5 * BETA)
    hgrn_lb_logits = 0.5 * nrm(ks[4], (DEPTH, HGRN_HEADS * HGRN_DK), jnp.float32)
    mlstm_w_in = nrm(ks[5], (N_MLSTM, D, MLSTM_IN_W), jnp.float32) * D ** -0.5
    mlstm_conv_w = nrm(ks[6], (N_MLSTM, MLSTM_CONV, 2 * MLSTM_QK_W), jnp.float32) * MLSTM_CONV ** -0.5
    i_bias = 0.1 * nrm(ks[7], (N_MLSTM, MLSTM_HEADS), jnp.float32)
    f_bias = jnp.linspace(3.0, 6.0, MLSTM_HEADS, dtype=jnp.float32)[None] + 0.1 * nrm(ks[8], (N_MLSTM, MLSTM_HEADS), jnp.float32)
    mlstm_gate_b = jnp.concatenate([i_bias, f_bias], axis=-1)
    mlstm_norm_w = 1.0 + 0.02 * nrm(ks[9], (N_MLSTM, D), jnp.float32)
    mlstm_w_out = nrm(ks[10], (N_MLSTM, D, D), jnp.float32) * (D ** -0.5 * BETA)
    s5_w_in = nrm(ks[11], (N_S5, D, D), jnp.float32) * D ** -0.5
    s5_a_re = -0.5 + 0.01 * nrm(ks[12], (N_S5, S5_GROUPS, S5_STATE), jnp.float32)
    s5_a_im = (jnp.pi * jnp.arange(S5_STATE, dtype=jnp.float32))[None, None] + 0.01 * nrm(ks[13], (N_S5, S5_GROUPS, S5_STATE), jnp.float32)
    s5_log_dt = jax.random.uniform(ks[14], (N_S5, S5_GROUPS), jnp.float32, math.log(S5_DT_MIN), math.log(S5_DT_MAX))
    s5_b_re = nrm(ks[15], (N_S5, S5_GROUPS, S5_STATE, S5_GROUP_CH), jnp.float32) * (2 * S5_GROUP_CH) ** -0.5
    s5_b_im = nrm(ks[16], (N_S5, S5_GROUPS, S5_STATE, S5_GROUP_CH), jnp.float32) * (2 * S5_GROUP_CH) ** -0.5
    s5_c_re = nrm(ks[17], (N_S5, S5_GROUPS, S5_GROUP_CH, S5_STATE), jnp.float32) * S5_STATE ** -0.5
    s5_c_im = nrm(ks[18], (N_S5, S5_GROUPS, S5_GROUP_CH, S5_STATE), jnp.float32) * S5_STATE ** -0.5
    s5_d = nrm(ks[19], (N_S5, D), jnp.float32)
    s5_w_out = nrm(ks[20], (N_S5, D, 2 * D), jnp.float32) * (D ** -0.5 * BETA)
    ffn_w_gate_up = nrm(ks[21], (DEPTH, D, 2 * FFN_HIDDEN), jnp.float32) * D ** -0.5
    ffn_w_down = nrm(ks[22], (DEPTH, FFN_HIDDEN, D), jnp.float32) * (FFN_HIDDEN ** -0.5 * BETA)
    kg, kb = jax.random.split(ks[23])
    ln_g = 1.0 + 0.02 * nrm(kg, (DEPTH, 2, D), jnp.float32)
    ln_b = 0.02 * nrm(kb, (DEPTH, 2, D), jnp.float32)
    return {"x": x, "hgrn_w_in": hgrn_w_in, "hgrn_norm_w": hgrn_norm_w, "hgrn_w_out": hgrn_w_out,
            "hgrn_lb_logits": hgrn_lb_logits, "mlstm_w_in": mlstm_w_in, "mlstm_conv_w": mlstm_conv_w,
            "mlstm_gate_b": mlstm_gate_b, "mlstm_norm_w": mlstm_norm_w, "mlstm_w_out": mlstm_w_out,
            "s5_w_in": s5_w_in, "s5_a_re": s5_a_re, "s5_a_im": s5_a_im, "s5_log_dt": s5_log_dt,
            "s5_b_re": s5_b_re, "s5_b_im": s5_b_im, "s5_c_re": s5_c_re, "s5_c_im": s5_c_im,
            "s5_d": s5_d, "s5_w_out": s5_w_out, "ffn_w_gate_up": ffn_w_gate_up, "ffn_w_down": ffn_w_down,
            "ln_g": ln_g, "ln_b": ln_b}


def reference(x, hgrn_w_in, hgrn_norm_w, hgrn_w_out, hgrn_lb_logits, mlstm_w_in, mlstm_conv_w,
              mlstm_gate_b, mlstm_norm_w, mlstm_w_out, s5_w_in, s5_a_re, s5_a_im, s5_log_dt,
              s5_b_re, s5_b_im, s5_c_re, s5_c_im, s5_d, s5_w_out, ffn_w_gate_up, ffn_w_down,
              ln_g, ln_b):
    lb_all = _hgrn_lower_bounds(hgrn_lb_logits)
    for i in range(DEPTH):
        kind = i % N_MIXERS
        j = i // N_MIXERS
        if kind == 0:
            h = _hgrn2_mixer(x, hgrn_w_in[j], hgrn_norm_w[j], hgrn_w_out[j], lb_all[i])
        elif kind == 1:
            h = _mlstm_mixer(x, mlstm_w_in[j], mlstm_conv_w[j], mlstm_gate_b[j], mlstm_norm_w[j], mlstm_w_out[j])
        else:
            h = _s5_mixer(x, s5_w_in[j], s5_a_re[j], s5_a_im[j], s5_log_dt[j], s5_b_re[j], s5_b_im[j],
                          s5_c_re[j], s5_c_im[j], s5_d[j], s5_w_out[j])
        x = _layernorm(ALPHA * x + h, ln_g[i, 0], ln_b[i, 0])
        x = _layernorm(ALPHA * x + _swiglu(x, ffn_w_gate_up[i], ffn_w_down[i]), ln_g[i, 1], ln_b[i, 1])
    return x
```

```cpp
#include <hip/hip_runtime.h>
#include <cstdint>
#include <cstdio>

constexpr int L = 16384, D = 1024, FF = 2816;
constexpr float ALPHA = 1.681792830507429f;
constexpr float LN_EPS = 1e-5f, HN_EPS = 1e-6f;

__device__ __forceinline__ float sigmoidf_(float x) { return 1.f / (1.f + __expf(-x)); }
__device__ __forceinline__ float siluf_(float x) { return x * sigmoidf_(x); }
__device__ __forceinline__ float logsigmoidf_(float x) { return fminf(x, 0.f) - log1pf(expf(-fabsf(x))); }
__device__ __forceinline__ float gelu_tanh_(float x) { return 0.5f * x * (1.f + tanhf(0.7978845608028654f * (x + 0.044715f * x * x * x))); }

template <int MODE>
__global__ void __launch_bounds__(256) sgemm(const float* __restrict__ A, const float* __restrict__ B, float* __restrict__ C, int M, int N, int K, int ldb, int ldc) {
    __shared__ float As[16][68];
    __shared__ float Bs[16][64];
    __shared__ float Bs2[MODE == 1 ? 16 : 1][64];
    const int tx = threadIdx.x & 15, ty = threadIdx.x >> 4;
    const int m0 = blockIdx.y * 64, n0 = blockIdx.x * 64;
    float acc[4][4] = {}, acc2[4][4] = {};
    for (int k0 = 0; k0 < K; k0 += 16) {
        {
            for (int i = 0; i < 4; ++i) { const int e = threadIdx.x + i * 256; const int r = e >> 4, c = e & 15; As[c][r] = A[(size_t)(m0 + r) * K + k0 + c]; }
            for (int i = 0; i < 4; ++i) { const int e = threadIdx.x + i * 256; const int r = e >> 6, c = e & 63; const int col = n0 + c;
                Bs[r][c] = col < N ? B[(size_t)(k0 + r) * ldb + col] : 0.f;
                if (MODE == 1) Bs2[r][c] = col < N ? B[(size_t)(k0 + r) * ldb + col + N] : 0.f; }
        }
        __syncthreads();
#pragma unroll
        for (int k = 0; k < 16; ++k) {
            float a[4], b[4], b2[4];
#pragma unroll
            for (int i = 0; i < 4; ++i) a[i] = As[k][ty * 4 + i];
#pragma unroll
            for (int j = 0; j < 4; ++j) { b[j] = Bs[k][tx * 4 + j]; if (MODE == 1) b2[j] = Bs2[k][tx * 4 + j]; }
#pragma unroll
            for (int i = 0; i < 4; ++i)
#pragma unroll
                for (int j = 0; j < 4; ++j) { acc[i][j] += a[i] * b[j]; if (MODE == 1) acc2[i][j] += a[i] * b2[j]; }
        }
        __syncthreads();
    }
    for (int i = 0; i < 4; ++i)
        for (int j = 0; j < 4; ++j) { const int r = m0 + ty * 4 + i, c = n0 + tx * 4 + j; if (c < N) C[(size_t)r * ldc + c] = MODE == 1 ? siluf_(acc[i][j]) * acc2[i][j] : acc[i][j]; }
}

__global__ void __launch_bounds__(256) ln_res(const float* xin, const float* h, float* xout, const float* __restrict__ g, const float* __restrict__ b) {
    const int row = blockIdx.x * 4 + (threadIdx.x >> 6), lane = threadIdx.x & 63;
    float v[16]; float s = 0.f;
    for (int j = 0; j < 16; ++j) { const int c = lane + 64 * j; v[j] = ALPHA * xin[(size_t)row * D + c] + h[(size_t)row * D + c]; s += v[j]; }
    for (int o = 1; o < 64; o <<= 1) s += __shfl_xor(s, o);
    const float mean = s * (1.f / D); float q = 0.f;
    for (int j = 0; j < 16; ++j) { v[j] -= mean; q += v[j] * v[j]; }
    for (int o = 1; o < 64; o <<= 1) q += __shfl_xor(q, o);
    const float rstd = rsqrtf(q * (1.f / D) + LN_EPS);
    for (int j = 0; j < 16; ++j) { const int c = lane + 64 * j; xout[(size_t)row * D + c] = v[j] * rstd * g[c] + b[c]; }
}

__global__ void hgrn_lb_kernel(const float* __restrict__ logits, float* __restrict__ lb  ) {
    const int c = blockIdx.x * blockDim.x + threadIdx.x; if (c >= D) return;
    float l[4], mx = -1e30f; for (int i = 0; i < 4; ++i) { l[i] = logits[i * D + c]; mx = fmaxf(mx, l[i]); }
    float e[4], s = 0.f; for (int i = 0; i < 4; ++i) { e[i] = expf(l[i] - mx); s += e[i]; }
    float cs = 0.f, c0 = 0.f; for (int i = 0; i < 4; ++i) { cs += e[i] / s; if (i == 0) c0 = cs; lb[i * D + c] = cs - c0; }
}

__global__ void __launch_bounds__(128) hgrn_naive(const float* __restrict__ proj  , const float* __restrict__ lbv  , const float* __restrict__ norm_w  , float* __restrict__ mix  ) {
    __shared__ float sq[128], sf[128], sk[128], red[2];
    const int h = blockIdx.x, e = threadIdx.x, col = h * 128 + e;
    float S[128];
#pragma unroll
    for (int d = 0; d < 128; ++d) S[d] = 0.f;
    const float lb = lbv[col], nw = norm_w[e];
    for (int t = 0; t < L; ++t) {
        const float* pr = proj + (size_t)t * 4096;
        const float qr = pr[col], fr = pr[1024 + col], v = pr[2048 + col], gr = pr[3072 + col];
        const float sg = sigmoidf_(fr);
        const float ft = lb + (1.f - lb) * sg;
        const float kt = (1.f - lb) * sigmoidf_(-fr);
        sq[e] = siluf_(qr); sf[e] = ft; sk[e] = kt;
        __syncthreads();
        float o = 0.f;
#pragma unroll
        for (int d = 0; d < 128; ++d) { S[d] = sf[d] * S[d] + sk[d] * v; o += sq[d] * S[d]; }
        float ss = o * o;
        for (int off = 1; off < 64; off <<= 1) ss += __shfl_xor(ss, off);
        if ((e & 63) == 0) red[e >> 6] = ss;
        __syncthreads();
        const float tot = red[0] + red[1];
        mix[(size_t)t * D + col] = o * rsqrtf(tot * (1.f / 128.f) + HN_EPS) * nw * siluf_(gr);
        __syncthreads();
    }
}

__global__ void __launch_bounds__(128) mlstm_naive(const float* __restrict__ proj  , const float* __restrict__ conv_w  , const float* __restrict__ gate_b  ,
                                                   const float* __restrict__ norm_w  , float* __restrict__ mix) {
    __shared__ float sq[64], sk[64], red[2];
    const int h = blockIdx.x, e = threadIdx.x;
    constexpr int W = 3088;
    const int cch = e < 64 ? h * 64 + e : 512 + h * 64 + (e - 64);
    const float cw0 = conv_w[cch], cw1 = conv_w[1024 + cch], cw2 = conv_w[2048 + cch], cw3 = conv_w[3072 + cch];
    float p0 = 0.f, p1 = 0.f, p2 = 0.f;
    float C[64], n[64];
#pragma unroll
    for (int d = 0; d < 64; ++d) { C[d] = 0.f; n[d] = 0.f; }
    const float bi = gate_b[h], bf = gate_b[8 + h], nw = norm_w[h * 128 + e];
    for (int t = 0; t < L; ++t) {
        const float* pr = proj + (size_t)t * W;
        const float u = pr[cch];
        float cv = cw0 * p0 + cw1 * p1 + cw2 * p2 + cw3 * u; p0 = p1; p1 = p2; p2 = u;
        cv = siluf_(cv);
        if (e < 64) sq[e] = cv; else sk[e - 64] = cv * 0.125f;
        const float v = pr[1024 + h * 128 + e], op = pr[2048 + h * 128 + e];
        const float gi = pr[3072 + h] + bi, gf = pr[3080 + h] + bf;
        const float it = expf(gi), ft = sigmoidf_(gf);
        __syncthreads();
        float num = 0.f, den = 0.f;
#pragma unroll
        for (int d = 0; d < 64; ++d) { const float kk = it * sk[d]; C[d] = ft * C[d] + kk * v; n[d] = ft * n[d] + kk; num += sq[d] * C[d]; den += sq[d] * n[d]; }
        const float hh = num / fmaxf(fabsf(den), 1.f);
        float ss = hh * hh;
        for (int off = 1; off < 64; off <<= 1) ss += __shfl_xor(ss, off);
        if ((e & 63) == 0) red[e >> 6] = ss;
        __syncthreads();
        const float tot = red[0] + red[1];
        mix[(size_t)t * D + h * 128 + e] = hh * rsqrtf(tot * (1.f / 128.f) + HN_EPS) * nw * sigmoidf_(op);
        __syncthreads();
    }
}

__global__ void __launch_bounds__(64) s5_naive(const float* __restrict__ u  , const float* __restrict__ a_re, const float* __restrict__ a_im, const float* __restrict__ log_dt,
                                               const float* __restrict__ b_re, const float* __restrict__ b_im, const float* __restrict__ c_re, const float* __restrict__ c_im,
                                               const float* __restrict__ dsk, float* __restrict__ mix) {
    __shared__ float ssr[64], ssi[64];
    const int g = blockIdx.x, p = threadIdx.x;
    const float dt = expf(log_dt[g]);
    const float ar = a_re[g * 64 + p], ai = a_im[g * 64 + p];
    const float mag = expf(ar * dt);
    const float abr = mag * cosf(ai * dt), abi = mag * sinf(ai * dt);
    const float nr = abr - 1.f, ni = abi, den = ar * ar + ai * ai;
    const float cr = (nr * ar + ni * ai) / den, ci = (ni * ar - nr * ai) / den;
    float bbr[16], bbi[16];
    for (int c = 0; c < 16; ++c) { const float br = b_re[(g * 64 + p) * 16 + c], bim = b_im[(g * 64 + p) * 16 + c]; bbr[c] = cr * br - ci * bim; bbi[c] = cr * bim + ci * br; }
    const int oc = p & 15, oq = p >> 4;
    float ccr[16], cci[16];
    for (int j = 0; j < 16; ++j) { ccr[j] = c_re[(g * 16 + oc) * 64 + oq * 16 + j]; cci[j] = c_im[(g * 16 + oc) * 64 + oq * 16 + j]; }
    const float dk = dsk[g * 16 + oc];
    float sr = 0.f, si = 0.f;
    for (int t = 0; t < L; ++t) {
        const float* ur = u + (size_t)t * D + g * 16;
        float br = 0.f, bi = 0.f;
#pragma unroll
        for (int c = 0; c < 16; ++c) { const float uu = ur[c]; br += bbr[c] * uu; bi += bbi[c] * uu; }
        const float nsr = abr * sr - abi * si + br, nsi = abr * si + abi * sr + bi; sr = nsr; si = nsi;
        ssr[p] = sr; ssi[p] = si;
        __syncthreads();
        float y = 0.f;
#pragma unroll
        for (int j = 0; j < 16; ++j) y += ssr[oq * 16 + j] * ccr[j] - ssi[oq * 16 + j] * cci[j];
        y += __shfl_xor(y, 16); y += __shfl_xor(y, 32);
        if (oq == 0) { y += dk * ur[oc]; mix[(size_t)t * D + g * 16 + oc] = gelu_tanh_(y); }
        __syncthreads();
    }
}

__global__ void glu_kernel(const float* __restrict__ z, float* __restrict__ h) {
    const size_t i = (size_t)blockIdx.x * blockDim.x + threadIdx.x; const size_t m = i / D, c = i % D;
    h[i] = z[m * 2048 + c] * sigmoidf_(z[m * 2048 + 1024 + c]);
}

static void gemm(hipStream_t st, const float* A, const float* B, float* C, int M, int N, int K, int ldb, int ldc, int mode) {
    dim3 grid((N + 63) / 64, M / 64);
    if (mode == 0) sgemm<0><<<grid, 256, 0, st>>>(A, B, C, M, N, K, ldb, ldc);
    else sgemm<1><<<grid, 256, 0, st>>>(A, B, C, M, N, K, ldb, ldc);
}

extern "C" void kernel_launch(void* const* d_in, const int* in_sizes, int n_in, void* d_out, int out_size, void* d_ws, size_t ws_size, hipStream_t stream) {
    const float* x = (const float*)d_in[0];
    const float* hgrn_w_in = (const float*)d_in[1]; const float* hgrn_norm_w = (const float*)d_in[2]; const float* hgrn_w_out = (const float*)d_in[3]; const float* hgrn_lb_logits = (const float*)d_in[4];
    const float* mlstm_w_in = (const float*)d_in[5]; const float* mlstm_conv_w = (const float*)d_in[6]; const float* mlstm_gate_b = (const float*)d_in[7]; const float* mlstm_norm_w = (const float*)d_in[8]; const float* mlstm_w_out = (const float*)d_in[9];
    const float* s5_w_in = (const float*)d_in[10]; const float* s5_a_re = (const float*)d_in[11]; const float* s5_a_im = (const float*)d_in[12]; const float* s5_log_dt = (const float*)d_in[13];
    const float* s5_b_re = (const float*)d_in[14]; const float* s5_b_im = (const float*)d_in[15]; const float* s5_c_re = (const float*)d_in[16]; const float* s5_c_im = (const float*)d_in[17];
    const float* s5_d = (const float*)d_in[18]; const float* s5_w_out = (const float*)d_in[19];
    const float* ffn_w_gate_up = (const float*)d_in[20]; const float* ffn_w_down = (const float*)d_in[21]; const float* ln_g = (const float*)d_in[22]; const float* ln_b = (const float*)d_in[23];
    float* out = (float*)d_out;
    char* ws = (char*)d_ws;
    const size_t MiB = 1u << 20;
    if (ws_size < 336 * MiB) { fprintf(stderr, "ws too small: %zu\n", ws_size); return; }
    float* proj = (float*)(ws);
    float* mix = (float*)(ws + 256 * MiB);
    float* lb = (float*)(ws + 320 * MiB);
    float* hbuf = (float*)(ws);
    float* Hff = (float*)(ws);
    float* dn = (float*)(ws + 192 * MiB);

    hgrn_lb_kernel<<<4, 256, 0, stream>>>(hgrn_lb_logits, lb);
    const float* xc = x;
    for (int i = 0; i < 4; ++i) {
        const int kind = i % 3, j = i / 3;
        if (kind == 0) {
            gemm(stream, xc, hgrn_w_in + (size_t)j * D * 4096, proj, L, 4096, D, 4096, 4096, 0);
            hgrn_naive<<<8, 128, 0, stream>>>(proj, lb + i * D, hgrn_norm_w + j * 128, mix);
            gemm(stream, mix, hgrn_w_out + (size_t)j * D * D, hbuf, L, D, D, D, D, 0);
        } else if (kind == 1) {
            gemm(stream, xc, mlstm_w_in, proj, L, 3088, D, 3088, 3088, 0);
            mlstm_naive<<<8, 128, 0, stream>>>(proj, mlstm_conv_w, mlstm_gate_b, mlstm_norm_w, mix);
            gemm(stream, mix, mlstm_w_out, hbuf, L, D, D, D, D, 0);
        } else {
            gemm(stream, xc, s5_w_in, proj, L, D, D, D, D, 0);
            s5_naive<<<64, 64, 0, stream>>>(proj, s5_a_re, s5_a_im, s5_log_dt, s5_b_re, s5_b_im, s5_c_re, s5_c_im, s5_d, mix);
            float* z = (float*)(ws + 64 * MiB);
            gemm(stream, mix, s5_w_out, z, L, 2048, D, 2048, 2048, 0);
            glu_kernel<<<(L * D) / 256, 256, 0, stream>>>(z, hbuf);
        }
        ln_res<<<L / 4, 256, 0, stream>>>(xc, hbuf, out, ln_g + (i * 2 + 0) * D, ln_b + (i * 2 + 0) * D);
        xc = out;
        gemm(stream, xc, ffn_w_gate_up + (size_t)i * D * 2 * FF, Hff, L, FF, D, 2 * FF, FF, 1);
        gemm(stream, Hff, ffn_w_down + (size_t)i * FF * D, dn, L, D, FF, D, D, 0);
        ln_res<<<L / 4, 256, 0, stream>>>(xc, dn, out, ln_g + (i * 2 + 1) * D, ln_b + (i * 2 + 1) * D);
    }
}
```

```cpp
#include <hip/hip_runtime.h>
#include <cstdint>
#include <cstdio>

constexpr int L = 16384, D = 1024, FF = 2816;
constexpr float ALPHA = 1.681792830507429f;
constexpr float LN_EPS = 1e-5f, HN_EPS = 1e-6f;

__device__ __forceinline__ float sigmoidf_(float x) { return 1.f / (1.f + __expf(-x)); }
__device__ __forceinline__ float siluf_(float x) { return x * sigmoidf_(x); }
__device__ __forceinline__ float logsigmoidf_(float x) { return fminf(x, 0.f) - log1pf(expf(-fabsf(x))); }
__device__ __forceinline__ float gelu_tanh_(float x) { return 0.5f * x * (1.f + tanhf(0.7978845608028654f * (x + 0.044715f * x * x * x))); }
namespace pg8 {
#define PG8_LAS __attribute__((address_space(3)))
typedef unsigned short bf16_t;
typedef short bf16x8 __attribute__((ext_vector_type(8)));
typedef float f32x4 __attribute__((ext_vector_type(4)));
typedef unsigned u32x4 __attribute__((ext_vector_type(4)));
constexpr int BM = 256, BK = 64, HALF = 128, HTB = HALF * BK * 2  , STAGE_BYTES = 8 * HTB, NXCD = 8, WGM = 8;

__host__ __device__ __forceinline__ int lds_byte(int r, int c) { const int st = (r >> 4) * 2 + (c >> 5), rr = r & 15, cc = c & 31, ob = rr * 64 + cc * 2; return st * 1024 + (ob ^ (((ob >> 9) & 1) << 5)); }
__host__ __device__ __forceinline__ void stage_rc(int b, int& R, int& C) { const int st = b / 1024, sb = b % 1024, swz = sb ^ (((sb >> 9) & 1) << 5); R = (st >> 1) * 16 + swz / 64; C = (st & 1) * 32 + (swz % 64) / 2; }
__host__ __device__ __forceinline__ int perm32(int rho) { const int n = rho >> 4, i = rho & 15; return 8 * (i >> 2) + 4 * n + (i & 3); }

struct Unit { int pm, pn; };
struct Gemm { const bf16_t* A; const bf16_t* Bt; int M, N, K, pad; };

struct StaticOrder {
    int nM, nN, nwg, G, c;
    __host__ __device__ void init(int M, int N, int G_, int c_) { nM = M / BM; nN = N / BM; nwg = nM * nN; G = G_; c = c_; }
    __host__ __device__ bool next(int i, Unit& u) const {
        const long L = (long)i * G + c; if (L >= nwg) return false;
        int wgid = (int)L; { const int q = nwg / NXCD, r = nwg % NXCD, xcd = wgid % NXCD, off = wgid / NXCD; wgid = (xcd < r ? xcd * (q + 1) : r * (q + 1) + (xcd - r) * q) + off; }
        const int nig = WGM * nN, gid = wgid / nig, fm = gid * WGM, gsz = (nM - fm) < WGM ? (nM - fm) : WGM;
        u.pm = fm + ((wgid % nig) % gsz); u.pn = (wgid % nig) / gsz; return true;
    }
    __device__ __forceinline__ void a_ready(const Unit&) const {}
    __device__ __forceinline__ void done(const Unit&) const {}
};

__device__ __forceinline__ unsigned cvt_pk_bf16(float lo, float hi) { unsigned r; asm volatile("v_cvt_pk_bf16_f32 %0, %1, %2" : "=v"(r) : "v"(lo), "v"(hi)); return r; }
typedef float f32x2 __attribute__((ext_vector_type(2)));
struct PanelStats {
    unsigned* xbuf;
    unsigned* cnt;
    unsigned* tmo;
    int ntn; float eps;
    unsigned code;
    __device__ __forceinline__ bool run(const f32x4 (&v)[2][2][4][2], const Unit& u, int wr, int wc, int fr, int fq, PG8_LAS unsigned char* lds, int wid, int lane) const {
        typedef float f32x2v __attribute__((ext_vector_type(2)));
        PG8_LAS f32x2v* P = (PG8_LAS f32x2v*)lds;
        PG8_LAS f32x2v* S = (PG8_LAS f32x2v*)(lds + 8192);
        PG8_LAS unsigned* flag = (PG8_LAS unsigned*)(lds + 8192 + 2048);
#pragma unroll
        for (int ai = 0; ai < 2; ++ai)
#pragma unroll
            for (int m = 0; m < 4; ++m) {
                float s = 0.f;
#pragma unroll
                for (int bj = 0; bj < 2; ++bj)
#pragma unroll
                    for (int n = 0; n < 2; ++n) { const f32x4 x = v[ai][bj][m][n]; s += (x[0] + x[1]) + (x[2] + x[3]); }
                s += __shfl_xor(s, 16); s += __shfl_xor(s, 32);
                const float mw = s * (1.0f / 64.0f); float q = 0.f;
#pragma unroll
                for (int bj = 0; bj < 2; ++bj)
#pragma unroll
                    for (int n = 0; n < 2; ++n) { const f32x4 d = v[ai][bj][m][n] - mw; q += (d[0] * d[0] + d[1] * d[1]) + (d[2] * d[2] + d[3] * d[3]); }
                q += __shfl_xor(q, 16); q += __shfl_xor(q, 32);
                if (fq == 0) P[(ai * HALF + wr * 64 + m * 16 + fr) * 4 + wc] = (f32x2v){mw, q};
            }
        asm volatile("s_waitcnt lgkmcnt(0)" ::: "memory"); __builtin_amdgcn_s_barrier(); asm volatile("" ::: "memory");
#if defined(BROKEN_EXCHANGE_NO_WAIT)
#warning BROKEN CONTROL BUILD: the row-statistics exchange does not wait; results are wrong by design
        if (blockIdx.x >= 64) { const long long t0_ = clock64(); while (clock64() - t0_ < 60000) __builtin_amdgcn_s_sleep(8); }
#endif
        const int row = wid * 32 + (lane & 31);
        if (lane < 32) {
            const f32x2v a = P[row * 4 + 0], b = P[row * 4 + 1], c = P[row * 4 + 2], d = P[row * 4 + 3];
            const float mt = (a.x + b.x + c.x + d.x) * 0.25f;
            const float da = a.x - mt, db = b.x - mt, dc = c.x - mt, dd = d.x - mt;
            const float m2 = (a.y + b.y) + (c.y + d.y) + 64.0f * ((da * da + db * db) + (dc * dc + dd * dd));
            unsigned long long* slot = (unsigned long long*)xbuf + ((size_t)(u.pm * BM + row) * 4 + u.pn);
            __hip_atomic_store(slot, ((unsigned long long)__float_as_uint(m2) << 32) | __float_as_uint(mt), __ATOMIC_RELAXED, __HIP_MEMORY_SCOPE_AGENT);
        }
        asm volatile("s_waitcnt vmcnt(0)" ::: "memory");
        if (lane == 0) __hip_atomic_fetch_add(cnt + 64 * u.pm, 1u, __ATOMIC_RELAXED, __HIP_MEMORY_SCOPE_AGENT);
        if (wid == 0) {
            bool dead = false; const unsigned long long t0 = __builtin_amdgcn_s_memrealtime(); const unsigned want = 8u * (unsigned)ntn;
            for (;;) {
#if defined(BROKEN_EXCHANGE_NO_WAIT)
                break;
#endif
                if ((unsigned)__builtin_amdgcn_readfirstlane(__hip_atomic_load(cnt + 64 * u.pm, __ATOMIC_RELAXED, __HIP_MEMORY_SCOPE_AGENT)) >= want) break;
                if (__builtin_amdgcn_s_memrealtime() - t0 > 2000000ull) {
                    if (lane == 0) { unsigned expect = 0u; __hip_atomic_compare_exchange_strong(tmo + 1, &expect, code | (unsigned)(u.pm & 0xff), __ATOMIC_RELAXED, __ATOMIC_RELAXED, __HIP_MEMORY_SCOPE_AGENT);
                                     __hip_atomic_store(tmo, 1u, __ATOMIC_RELAXED, __HIP_MEMORY_SCOPE_AGENT); }
                    dead = true; break; }
                __builtin_amdgcn_s_sleep(2);
            }
            __builtin_amdgcn_fence(__ATOMIC_ACQUIRE, "agent");
            if (lane == 0) flag[0] = dead ? 1u : 0u;
        }
        asm volatile("s_waitcnt vmcnt(0) lgkmcnt(0)" ::: "memory"); __builtin_amdgcn_s_barrier(); asm volatile("" ::: "memory");
        const bool bad = flag[0] != 0u;
        if (lane < 32) {
            const unsigned long long* slot = (const unsigned long long*)xbuf + (size_t)(u.pm * BM + row) * 4; float mt[4], m2[4]; float ms = 0.f;
#pragma unroll
            for (int t = 0; t < 4; ++t) { if (t < ntn) { const unsigned long long w = __hip_atomic_load(slot + t, __ATOMIC_RELAXED, __HIP_MEMORY_SCOPE_AGENT); mt[t] = __uint_as_float((unsigned)w); m2[t] = __uint_as_float((unsigned)(w >> 32)); } else { mt[t] = 0.f; m2[t] = 0.f; } ms += mt[t]; }
            const float mean = ms / (float)ntn; float q = 0.f;
#pragma unroll
            for (int t = 0; t < 4; ++t) if (t < ntn) { const float dm = mt[t] - mean; q += m2[t] + 256.0f * dm * dm; }
            S[row] = (f32x2v){mean, 1.0f / sqrtf(q / (256.0f * (float)ntn) + eps)};
        }
        asm volatile("s_waitcnt lgkmcnt(0)" ::: "memory"); __builtin_amdgcn_s_barrier(); asm volatile("" ::: "memory");
        return bad;
    }
};
struct EpiF32N {
    static constexpr bool PERM = false, AFTER_DRAIN = false;
    float* C; int ldc; int nvalid;
    __device__ __forceinline__ void operator()(const f32x4 (&acc)[2][2][4][2], const Unit& u, int wr, int wc, int fr, int fq) const {
        const int row0 = u.pm * BM + wr * 64 + fr, col0 = u.pn * BM + wc * 32 + 4 * fq;
#pragma unroll
        for (int ai = 0; ai < 2; ++ai)
#pragma unroll
            for (int m = 0; m < 4; ++m) { float* rowp = C + (size_t)(row0 + ai * HALF + m * 16) * ldc;
#pragma unroll
                for (int bj = 0; bj < 2; ++bj)
#pragma unroll
                    for (int n = 0; n < 2; ++n) { const int c = col0 + bj * HALF + n * 16; if (c < nvalid) *(f32x4*)(rowp + c) = acc[ai][bj][m][n]; } }
    }
};
typedef unsigned u32x2 __attribute__((ext_vector_type(2)));
__device__ __forceinline__ float silu_f(float x) { return x / (1.f + __expf(-x)); }
struct EpiGateUp {
    static constexpr bool PERM = false, AFTER_DRAIN = false;
    bf16_t* Hh; int ldc, pad;
    __device__ __forceinline__ void operator()(const f32x4 (&acc)[2][2][4][2], const Unit& u, int wr, int wc, int fr, int fq) const {
        const int row0 = u.pm * BM + wr * 64 + fr, col0 = u.pn * HALF + wc * 32 + 4 * fq;
#pragma unroll
        for (int ai = 0; ai < 2; ++ai)
#pragma unroll
            for (int m = 0; m < 4; ++m) { bf16_t* rowp = Hh + (size_t)(row0 + ai * HALF + m * 16) * ldc + col0;
#pragma unroll
                for (int n = 0; n < 2; ++n) { const f32x4 g = acc[ai][0][m][n], up = acc[ai][1][m][n];
                    u32x2 w; w.x = cvt_pk_bf16(silu_f(g[0]) * up[0], silu_f(g[1]) * up[1]); w.y = cvt_pk_bf16(silu_f(g[2]) * up[2], silu_f(g[3]) * up[3]);
                    *(u32x2*)(rowp + n * 16) = w; } }
    }
};
template <class Epi, class Sched, bool ALIGN_EPI = false, bool SP2 = false>
__device__ __forceinline__ void gemm_phase(PG8_LAS unsigned char* lds, const Gemm g, const Sched& S, const Epi& E) {
    const int tid = threadIdx.x, wid = __builtin_amdgcn_readfirstlane(tid >> 6), lane = tid & 63, wr = wid >> 2, wc = wid & 3, fr = lane & 15, fq = lane >> 4;
    const int K = g.K, nt = K / BK;
    unsigned voffA[2], voffB[2];
#pragma unroll
    for (int i = 0; i < 2; ++i) { int R, C; stage_rc(tid * 16 + i * 8192, R, C); const int Rb = Epi::PERM ? ((R & ~31) + perm32(R & 31)) : R;
        voffA[i] = (unsigned)(R * K + C) * 2u; voffB[i] = (unsigned)(Rb * K + C) * 2u; }
    const size_t kstep = (size_t)(BK * 2);
    const size_t hstep = (size_t)HALF * K * 2;
    const size_t tstep = 2 * hstep;
    const unsigned ldsw = (unsigned)wid * 1024u;
    const int aoff = lds_byte(wr * 64 + fr, fq * 8), boff = lds_byte(wc * 32 + fr, fq * 8);
#define PG8_SA(b, h) (((b) * 2 + (h)) * HTB)
#define PG8_SB(b, h) ((4 + (b) * 2 + (h)) * HTB)
#define PG8_STAGE(bufoff, gbase, voff) do { _Pragma("unroll") for (int _i = 0; _i < 2; ++_i) \
        __builtin_amdgcn_global_load_lds((const unsigned*)((const char*)(gbase) + (voff)[_i]), (PG8_LAS unsigned*)(lds + (bufoff) + ldsw + _i * 8192), 16, 0, 0); } while (0)
#define PG8_LDA(dst, b, h) do { _Pragma("unroll") for (int m = 0; m < 4; ++m) _Pragma("unroll") for (int k = 0; k < 2; ++k) dst[m][k] = *(const PG8_LAS bf16x8*)(lds + PG8_SA(b, h) + aoff + m * 2048 + k * 1024); } while (0)
#define PG8_LDB(dst, b, h) do { _Pragma("unroll") for (int n = 0; n < 2; ++n) _Pragma("unroll") for (int k = 0; k < 2; ++k) dst[n][k] = *(const PG8_LAS bf16x8*)(lds + PG8_SB(b, h) + boff + n * 2048 + k * 1024); } while (0)
#define PG8_MMA(ai, bj, At, Bt) do { __builtin_amdgcn_s_setprio(1); _Pragma("unroll") for (int m = 0; m < 4; ++m) _Pragma("unroll") for (int n = 0; n < 2; ++n) _Pragma("unroll") for (int k = 0; k < 2; ++k) \
        acc[ai][bj][m][n] = __builtin_amdgcn_mfma_f32_16x16x32_bf16(Bt[n][k], At[m][k], acc[ai][bj][m][n], 0, 0, 0); __builtin_amdgcn_s_setprio(0); } while (0)
#define PG8_WAIT_V(n) asm volatile("s_waitcnt vmcnt(" #n ")" ::: "memory")
#define PG8_WAIT_L(n) asm volatile("s_waitcnt lgkmcnt(" #n ")" ::: "memory")
#define PG8_BAR __builtin_amdgcn_s_barrier()
#define PG8_SCHED __builtin_amdgcn_sched_barrier(0)
    Unit cur, nxt; int ui = 0;
    if (!S.next(0, cur)) return;
    f32x4 acc[2][2][4][2];
#pragma unroll
    for (int a = 0; a < 2; ++a)
#pragma unroll
        for (int b = 0; b < 2; ++b)
#pragma unroll
            for (int m = 0; m < 4; ++m)
#pragma unroll
                for (int n = 0; n < 2; ++n) acc[a][b][m][n] = (f32x4){0.f, 0.f, 0.f, 0.f};
    bf16x8 At[4][2], B0[2][2], B1[2][2];
    const char* cA = (const char*)g.A + (size_t)cur.pm * tstep; const char* cB = (const char*)g.Bt + (size_t)cur.pn * tstep;
    S.a_ready(cur);
    if constexpr (SP2) {
        PG8_STAGE(PG8_SB(0, 0), cB, voffB); PG8_STAGE(PG8_SB(0, 1), cB + hstep, voffB); PG8_STAGE(PG8_SA(0, 0), cA, voffA); PG8_STAGE(PG8_SA(0, 1), cA + hstep, voffA);
        if (wr == 1) PG8_BAR;
        PG8_WAIT_V(2); PG8_BAR;
        PG8_STAGE(PG8_SB(1, 0), cB + kstep, voffB); PG8_STAGE(PG8_SA(1, 0), cA + kstep, voffA); PG8_STAGE(PG8_SB(1, 1), cB + hstep + kstep, voffB);
        PG8_WAIT_V(6); PG8_BAR;
    } else {
        PG8_STAGE(PG8_SB(0, 0), cB, voffB); PG8_STAGE(PG8_SA(0, 0), cA, voffA); PG8_STAGE(PG8_SB(0, 1), cB + hstep, voffB); PG8_STAGE(PG8_SA(0, 1), cA + hstep, voffA);
        if (wr == 1) PG8_BAR;
        PG8_WAIT_V(4); PG8_BAR;
        PG8_STAGE(PG8_SB(1, 0), cB + kstep, voffB); PG8_STAGE(PG8_SA(1, 0), cA + kstep, voffA); PG8_STAGE(PG8_SB(1, 1), cB + hstep + kstep, voffB);
        PG8_WAIT_V(6); PG8_BAR;
    }
    for (;;) {
        const bool has_next = S.next(ui + 1, nxt);
        const char* nA = has_next ? (const char*)g.A + (size_t)nxt.pm * tstep : cA; const char* nB = has_next ? (const char*)g.Bt + (size_t)nxt.pn * tstep : cB;
        for (int t = 0; t < nt; t += 2) {
            const bool last = (t == nt - 2);
            const char* a1 = cA + (size_t)(t + 1) * kstep;
            const char* a2 = last ? nA : cA + (size_t)(t + 2) * kstep; const char* b2 = last ? nB : cB + (size_t)(t + 2) * kstep;
            const char* a3 = a2 + kstep; const char* b3 = b2 + kstep;
            if (last && has_next) S.a_ready(nxt);
            if constexpr (SP2) {
            PG8_LDB(B0, 0, 0); PG8_LDB(B1, 0, 1); PG8_SCHED; PG8_LDA(At, 0, 0); PG8_STAGE(PG8_SA(1, 1), a1 + hstep, voffA);
            PG8_WAIT_V(8); PG8_WAIT_L(0); PG8_BAR; PG8_MMA(0, 0, At, B0); PG8_MMA(0, 1, At, B1); PG8_BAR; PG8_SCHED;
            PG8_LDA(At, 0, 1); PG8_STAGE(PG8_SB(0, 0), b2, voffB); PG8_STAGE(PG8_SB(0, 1), b2 + hstep, voffB); PG8_STAGE(PG8_SA(0, 0), a2, voffA);
            PG8_WAIT_V(8); PG8_WAIT_L(0); PG8_BAR; PG8_MMA(1, 0, At, B0); PG8_MMA(1, 1, At, B1); PG8_BAR; PG8_SCHED;
            PG8_LDB(B0, 1, 0); PG8_LDB(B1, 1, 1); PG8_SCHED; PG8_LDA(At, 1, 0); PG8_STAGE(PG8_SA(0, 1), a2 + hstep, voffA);
            PG8_WAIT_V(8); PG8_WAIT_L(0); PG8_BAR; PG8_MMA(0, 0, At, B0); PG8_MMA(0, 1, At, B1); PG8_BAR; PG8_SCHED;
            PG8_LDA(At, 1, 1); PG8_STAGE(PG8_SB(1, 0), b3, voffB); PG8_STAGE(PG8_SB(1, 1), b3 + hstep, voffB); PG8_STAGE(PG8_SA(1, 0), a3, voffA);
            PG8_WAIT_V(8); PG8_WAIT_L(0); PG8_BAR; PG8_MMA(1, 0, At, B0); PG8_MMA(1, 1, At, B1); PG8_BAR; PG8_SCHED;
            } else {
            PG8_LDB(B0, 0, 0); PG8_SCHED; PG8_LDA(At, 0, 0); PG8_STAGE(PG8_SA(1, 1), a1 + hstep, voffA);
            PG8_WAIT_L(8); PG8_BAR; PG8_WAIT_L(0); PG8_MMA(0, 0, At, B0); PG8_BAR; PG8_SCHED;
            PG8_LDB(B1, 0, 1); PG8_STAGE(PG8_SB(0, 0), b2, voffB);
            PG8_BAR; PG8_WAIT_L(0); PG8_MMA(0, 1, At, B1); PG8_BAR;
            PG8_LDA(At, 0, 1); PG8_STAGE(PG8_SA(0, 0), a2, voffA);
            PG8_BAR; PG8_WAIT_L(0); PG8_MMA(1, 0, At, B0); PG8_BAR; PG8_SCHED;
            PG8_STAGE(PG8_SB(0, 1), b2 + hstep, voffB);
            PG8_WAIT_V(6); PG8_BAR; PG8_MMA(1, 1, At, B1); PG8_BAR;
            PG8_LDB(B0, 1, 0); PG8_SCHED; PG8_LDA(At, 1, 0); PG8_STAGE(PG8_SA(0, 1), a2 + hstep, voffA);
            PG8_WAIT_L(8); PG8_BAR; PG8_WAIT_L(0); PG8_MMA(0, 0, At, B0); PG8_BAR; PG8_SCHED;
            PG8_LDB(B1, 1, 1); PG8_STAGE(PG8_SB(1, 0), b3, voffB);
            PG8_BAR; PG8_WAIT_L(0); PG8_MMA(0, 1, At, B1); PG8_BAR;
            PG8_LDA(At, 1, 1); PG8_STAGE(PG8_SA(1, 0), a3, voffA);
            PG8_BAR; PG8_WAIT_L(0); PG8_MMA(1, 0, At, B0); PG8_BAR; PG8_SCHED;
            PG8_STAGE(PG8_SB(1, 1), b3 + hstep, voffB);
            PG8_WAIT_V(6); PG8_BAR; PG8_MMA(1, 1, At, B1); PG8_BAR;
            }
        }
        if constexpr (ALIGN_EPI) { if (wr == 0) PG8_BAR; }
        if constexpr (!Epi::AFTER_DRAIN) { E(acc, cur, wr, wc, fr, fq); S.done(cur); }
        if (!has_next) break;
#pragma unroll
        for (int a = 0; a < 2; ++a)
#pragma unroll
            for (int b = 0; b < 2; ++b)
#pragma unroll
                for (int m = 0; m < 4; ++m)
#pragma unroll
                    for (int n = 0; n < 2; ++n) acc[a][b][m][n] = (f32x4){0.f, 0.f, 0.f, 0.f};
        cur = nxt; cA = nA; cB = nB; ++ui;
        if constexpr (ALIGN_EPI) { if (wr == 1) PG8_BAR; }
    }
    PG8_WAIT_V(0);
    if constexpr (!ALIGN_EPI) { if (wr == 0) PG8_BAR; }
    PG8_BAR;
    if constexpr (Epi::AFTER_DRAIN) { E.fused(acc, cur, wr, wc, fr, fq, lds, wid, lane); S.done(cur); }
#undef PG8_SA
#undef PG8_SB
#undef PG8_STAGE
#undef PG8_LDA
#undef PG8_LDB
#undef PG8_MMA
#undef PG8_WAIT_V
#undef PG8_WAIT_L
#undef PG8_BAR
#undef PG8_SCHED
}
}
using pg8::bf16_t;
#define LAS __attribute__((address_space(3)))
__device__ __forceinline__ unsigned f2bf(float f) { unsigned u = __builtin_bit_cast(unsigned, f); return (u + 0x7fffu + ((u >> 16) & 1u)) >> 16; }
__device__ __forceinline__ unsigned pk2(float lo, float hi) { return f2bf(lo) | (f2bf(hi) << 16); }
typedef unsigned v4u __attribute__((ext_vector_type(4)));

template <class Epi>
__global__ void __launch_bounds__(512, 2) gemm_kernel(pg8::Gemm g, Epi E) {
    extern __shared__ __attribute__((aligned(16))) unsigned char lds[];
    pg8::StaticOrder S; S.init(g.M, g.N, (int)gridDim.x, (int)blockIdx.x);
    pg8::gemm_phase<Epi, pg8::StaticOrder, true, true>((LAS unsigned char*)lds, g, S, E);
}

__global__ void __launch_bounds__(256) wt_convert(const float* __restrict__ src, int K, int ldsrc, int nsrc, bf16_t* __restrict__ dst, int half) {
    __shared__ float tile[64][65];
    const int n0 = blockIdx.x * 64, k0 = blockIdx.y * 64, tid = threadIdx.x;
    for (int i = 0; i < 16; ++i) { const int e = tid + 256 * i, kk = e >> 6, nn = e & 63, n = n0 + nn;
        int col; bool ok;
        if (half == 0) { col = n; ok = n < nsrc; } else { const int t = n >> 8, w = n & 255; col = (w < 128 ? 0 : half) + t * 128 + (w & 127); ok = true; }
        tile[kk][nn] = ok ? src[(size_t)(k0 + kk) * ldsrc + col] : 0.f; }
    __syncthreads();
    const int nn = tid >> 2, kq = tid & 3;
    v4u o0, o1;
    o0.x = pk2(tile[kq * 16 + 0][nn], tile[kq * 16 + 1][nn]); o0.y = pk2(tile[kq * 16 + 2][nn], tile[kq * 16 + 3][nn]); o0.z = pk2(tile[kq * 16 + 4][nn], tile[kq * 16 + 5][nn]); o0.w = pk2(tile[kq * 16 + 6][nn], tile[kq * 16 + 7][nn]);
    o1.x = pk2(tile[kq * 16 + 8][nn], tile[kq * 16 + 9][nn]); o1.y = pk2(tile[kq * 16 + 10][nn], tile[kq * 16 + 11][nn]); o1.z = pk2(tile[kq * 16 + 12][nn], tile[kq * 16 + 13][nn]); o1.w = pk2(tile[kq * 16 + 14][nn], tile[kq * 16 + 15][nn]);
    v4u* d = (v4u*)(dst + (size_t)(n0 + nn) * K + k0 + kq * 16);
    d[0] = o0; d[1] = o1;
}
__global__ void __launch_bounds__(256) cvt_bf16(const float* __restrict__ src, bf16_t* __restrict__ dst) {
    const size_t i = ((size_t)blockIdx.x * 256 + threadIdx.x) * 8;
    const float4 a = *(const float4*)(src + i), b = *(const float4*)(src + i + 4);
    v4u o; o.x = pk2(a.x, a.y); o.y = pk2(a.z, a.w); o.z = pk2(b.x, b.y); o.w = pk2(b.z, b.w);
    *(v4u*)(dst + i) = o;
}

__global__ void __launch_bounds__(256) ln_res(const float* xin, const float* h, float* xout, const float* __restrict__ g, const float* __restrict__ b) {
    const int row = blockIdx.x * 4 + (threadIdx.x >> 6), lane = threadIdx.x & 63;
    float v[16]; float s = 0.f;
    for (int j = 0; j < 16; ++j) { const int c = lane + 64 * j; v[j] = ALPHA * xin[(size_t)row * D + c] + h[(size_t)row * D + c]; s += v[j]; }
    for (int o = 1; o < 64; o <<= 1) s += __shfl_xor(s, o);
    const float mean = s * (1.f / D); float q = 0.f;
    for (int j = 0; j < 16; ++j) { v[j] -= mean; q += v[j] * v[j]; }
    for (int o = 1; o < 64; o <<= 1) q += __shfl_xor(q, o);
    const float rstd = rsqrtf(q * (1.f / D) + LN_EPS);
    for (int j = 0; j < 16; ++j) { const int c = lane + 64 * j; xout[(size_t)row * D + c] = v[j] * rstd * g[c] + b[c]; }
}

__global__ void hgrn_lb_kernel(const float* __restrict__ logits, float* __restrict__ lb  ) {
    const int c = blockIdx.x * blockDim.x + threadIdx.x; if (c >= D) return;
    float l[4], mx = -1e30f; for (int i = 0; i < 4; ++i) { l[i] = logits[i * D + c]; mx = fmaxf(mx, l[i]); }
    float e[4], s = 0.f; for (int i = 0; i < 4; ++i) { e[i] = expf(l[i] - mx); s += e[i]; }
    float cs = 0.f, c0 = 0.f; for (int i = 0; i < 4; ++i) { cs += e[i] / s; if (i == 0) c0 = cs; lb[i * D + c] = cs - c0; }
}

__global__ void __launch_bounds__(128) hgrn_naive(const float* __restrict__ proj  , const float* __restrict__ lbv  , const float* __restrict__ norm_w  , float* __restrict__ mix  ) {
    __shared__ float sq[128], sf[128], sk[128], red[2];
    const int h = blockIdx.x, e = threadIdx.x, col = h * 128 + e;
    float S[128];
#pragma unroll
    for (int d = 0; d < 128; ++d) S[d] = 0.f;
    const float lb = lbv[col], nw = norm_w[e];
    for (int t = 0; t < L; ++t) {
        const float* pr = proj + (size_t)t * 4096;
        const float qr = pr[col], fr = pr[1024 + col], v = pr[2048 + col], gr = pr[3072 + col];
        const float sg = sigmoidf_(fr);
        const float ft = lb + (1.f - lb) * sg;
        const float kt = (1.f - lb) * sigmoidf_(-fr);
        sq[e] = siluf_(qr); sf[e] = ft; sk[e] = kt;
        __syncthreads();
        float o = 0.f;
#pragma unroll
        for (int d = 0; d < 128; ++d) { S[d] = sf[d] * S[d] + sk[d] * v; o += sq[d] * S[d]; }
        float ss = o * o;
        for (int off = 1; off < 64; off <<= 1) ss += __shfl_xor(ss, off);
        if ((e & 63) == 0) red[e >> 6] = ss;
        __syncthreads();
        const float tot = red[0] + red[1];
        mix[(size_t)t * D + col] = o * rsqrtf(tot * (1.f / 128.f) + HN_EPS) * nw * siluf_(gr);
        __syncthreads();
    }
}

__global__ void __launch_bounds__(128) mlstm_naive(const float* __restrict__ proj  , const float* __restrict__ conv_w  , const float* __restrict__ gate_b  ,
                                                   const float* __restrict__ norm_w  , float* __restrict__ mix) {
    __shared__ float sq[64], sk[64], red[2];
    const int h = blockIdx.x, e = threadIdx.x;
    constexpr int W = 3088;
    const int cch = e < 64 ? h * 64 + e : 512 + h * 64 + (e - 64);
    const float cw0 = conv_w[cch], cw1 = conv_w[1024 + cch], cw2 = conv_w[2048 + cch], cw3 = conv_w[3072 + cch];
    float p0 = 0.f, p1 = 0.f, p2 = 0.f;
    float C[64], n[64];
#pragma unroll
    for (int d = 0; d < 64; ++d) { C[d] = 0.f; n[d] = 0.f; }
    const float bi = gate_b[h], bf = gate_b[8 + h], nw = norm_w[h * 128 + e];
    for (int t = 0; t < L; ++t) {
        const float* pr = proj + (size_t)t * W;
        const float u = pr[cch];
        float cv = cw0 * p0 + cw1 * p1 + cw2 * p2 + cw3 * u; p0 = p1; p1 = p2; p2 = u;
        cv = siluf_(cv);
        if (e < 64) sq[e] = cv; else sk[e - 64] = cv * 0.125f;
        const float v = pr[1024 + h * 128 + e], op = pr[2048 + h * 128 + e];
        const float gi = pr[3072 + h] + bi, gf = pr[3080 + h] + bf;
        const float it = expf(gi), ft = sigmoidf_(gf);
        __syncthreads();
        float num = 0.f, den = 0.f;
#pragma unroll
        for (int d = 0; d < 64; ++d) { const float kk = it * sk[d]; C[d] = ft * C[d] + kk * v; n[d] = ft * n[d] + kk; num += sq[d] * C[d]; den += sq[d] * n[d]; }
        const float hh = num / fmaxf(fabsf(den), 1.f);
        float ss = hh * hh;
        for (int off = 1; off < 64; off <<= 1) ss += __shfl_xor(ss, off);
        if ((e & 63) == 0) red[e >> 6] = ss;
        __syncthreads();
        const float tot = red[0] + red[1];
        mix[(size_t)t * D + h * 128 + e] = hh * rsqrtf(tot * (1.f / 128.f) + HN_EPS) * nw * sigmoidf_(op);
        __syncthreads();
    }
}

__global__ void __launch_bounds__(64) s5_naive(const float* __restrict__ u  , const float* __restrict__ a_re, const float* __restrict__ a_im, const float* __restrict__ log_dt,
                                               const float* __restrict__ b_re, const float* __restrict__ b_im, const float* __restrict__ c_re, const float* __restrict__ c_im,
                                               const float* __restrict__ dsk, float* __restrict__ mix) {
    __shared__ float ssr[64], ssi[64];
    const int g = blockIdx.x, p = threadIdx.x;
    const float dt = expf(log_dt[g]);
    const float ar = a_re[g * 64 + p], ai = a_im[g * 64 + p];
    const float mag = expf(ar * dt);
    const float abr = mag * cosf(ai * dt), abi = mag * sinf(ai * dt);
    const float nr = abr - 1.f, ni = abi, den = ar * ar + ai * ai;
    const float cr = (nr * ar + ni * ai) / den, ci = (ni * ar - nr * ai) / den;
    float bbr[16], bbi[16];
    for (int c = 0; c < 16; ++c) { const float br = b_re[(g * 64 + p) * 16 + c], bim = b_im[(g * 64 + p) * 16 + c]; bbr[c] = cr * br - ci * bim; bbi[c] = cr * bim + ci * br; }
    const int oc = p & 15, oq = p >> 4;
    float ccr[16], cci[16];
    for (int j = 0; j < 16; ++j) { ccr[j] = c_re[(g * 16 + oc) * 64 + oq * 16 + j]; cci[j] = c_im[(g * 16 + oc) * 64 + oq * 16 + j]; }
    const float dk = dsk[g * 16 + oc];
    float sr = 0.f, si = 0.f;
    for (int t = 0; t < L; ++t) {
        const float* ur = u + (size_t)t * D + g * 16;
        float br = 0.f, bi = 0.f;
#pragma unroll
        for (int c = 0; c < 16; ++c) { const float uu = ur[c]; br += bbr[c] * uu; bi += bbi[c] * uu; }
        const float nsr = abr * sr - abi * si + br, nsi = abr * si + abi * sr + bi; sr = nsr; si = nsi;
        ssr[p] = sr; ssi[p] = si;
        __syncthreads();
        float y = 0.f;
#pragma unroll
        for (int j = 0; j < 16; ++j) y += ssr[oq * 16 + j] * ccr[j] - ssi[oq * 16 + j] * cci[j];
        y += __shfl_xor(y, 16); y += __shfl_xor(y, 32);
        if (oq == 0) { y += dk * ur[oc]; mix[(size_t)t * D + g * 16 + oc] = gelu_tanh_(y); }
        __syncthreads();
    }
}

__global__ void glu_kernel(const float* __restrict__ z, float* __restrict__ h) {
    const size_t i = (size_t)blockIdx.x * blockDim.x + threadIdx.x; const size_t m = i / D, c = i % D;
    h[i] = z[m * 2048 + c] * sigmoidf_(z[m * 2048 + 1024 + c]);
}

constexpr int GEMM_LDS = 131072;
template <class Epi> static void launch_gemm(hipStream_t st, const bf16_t* A, const bf16_t* Bt, int M, int N, int K, Epi E) {
    static bool init = false;
    if (!init) { (void)hipFuncSetAttribute((const void*)gemm_kernel<Epi>, hipFuncAttributeMaxDynamicSharedMemorySize, GEMM_LDS); init = true; }
    pg8::Gemm g{A, Bt, M, N, K, 0};
    hipLaunchKernelGGL(gemm_kernel<Epi>, dim3(256), dim3(512), GEMM_LDS, st, g, E);
}
static void convert_w(hipStream_t st, const float* src, int K, int ldsrc, int nsrc, int Npad, bf16_t* dst, int half) {
    wt_convert<<<dim3(Npad / 64, K / 64), 256, 0, st>>>(src, K, ldsrc, nsrc, dst, half);
}

extern "C" void kernel_launch(void* const* d_in, const int* in_sizes, int n_in, void* d_out, int out_size, void* d_ws, size_t ws_size, hipStream_t stream) {
    const float* x = (const float*)d_in[0];
    const float* hgrn_w_in = (const float*)d_in[1]; const float* hgrn_norm_w = (const float*)d_in[2]; const float* hgrn_w_out = (const float*)d_in[3]; const float* hgrn_lb_logits = (const float*)d_in[4];
    const float* mlstm_w_in = (const float*)d_in[5]; const float* mlstm_conv_w = (const float*)d_in[6]; const float* mlstm_gate_b = (const float*)d_in[7]; const float* mlstm_norm_w = (const float*)d_in[8]; const float* mlstm_w_out = (const float*)d_in[9];
    const float* s5_w_in = (const float*)d_in[10]; const float* s5_a_re = (const float*)d_in[11]; const float* s5_a_im = (const float*)d_in[12]; const float* s5_log_dt = (const float*)d_in[13];
    const float* s5_b_re = (const float*)d_in[14]; const float* s5_b_im = (const float*)d_in[15]; const float* s5_c_re = (const float*)d_in[16]; const float* s5_c_im = (const float*)d_in[17];
    const float* s5_d = (const float*)d_in[18]; const float* s5_w_out = (const float*)d_in[19];
    const float* ffn_w_gate_up = (const float*)d_in[20]; const float* ffn_w_down = (const float*)d_in[21]; const float* ln_g = (const float*)d_in[22]; const float* ln_b = (const float*)d_in[23];
    float* out = (float*)d_out;
    char* ws = (char*)d_ws;
    const size_t MiB = 1u << 20;
    if (ws_size < 344 * MiB) { fprintf(stderr, "ws too small: %zu\n", ws_size); return; }
    bf16_t* WB = (bf16_t*)(ws);
    float* proj = (float*)(ws + 16 * MiB);
    float* mix = (float*)(ws + 272 * MiB);
    bf16_t* A1 = (bf16_t*)(ws + 272 * MiB);
    bf16_t* A2 = (bf16_t*)(ws + 16 * MiB);
    float* hbuf = (float*)(ws + 48 * MiB);
    float* zbuf = (float*)(ws + 48 * MiB);
    float* hbuf5 = (float*)(ws + 176 * MiB);
    bf16_t* Hff = (bf16_t*)(ws + 48 * MiB);
    float* dn = (float*)(ws + 136 * MiB);
    float* lb = (float*)(ws + 340 * MiB);

    hgrn_lb_kernel<<<4, 256, 0, stream>>>(hgrn_lb_logits, lb);
    const float* xc = x;
    for (int i = 0; i < 4; ++i) {
        const int kind = i % 3, j = i / 3;
        cvt_bf16<<<L * D / 2048, 256, 0, stream>>>(xc, A1);
        float* hb = hbuf;
        if (kind == 0) {
            convert_w(stream, hgrn_w_in + (size_t)j * D * 4096, D, 4096, 4096, 4096, WB, 0);
            launch_gemm(stream, A1, WB, L, 4096, D, pg8::EpiF32N{proj, 4096, 4096});
            hgrn_naive<<<8, 128, 0, stream>>>(proj, lb + i * D, hgrn_norm_w + j * 128, mix);
            cvt_bf16<<<L * D / 2048, 256, 0, stream>>>(mix, A2);
            convert_w(stream, hgrn_w_out + (size_t)j * D * D, D, D, D, D, WB, 0);
            launch_gemm(stream, A2, WB, L, D, D, pg8::EpiF32N{hbuf, D, D});
        } else if (kind == 1) {
            convert_w(stream, mlstm_w_in, D, 3088, 3088, 3328, WB, 0);
            launch_gemm(stream, A1, WB, L, 3328, D, pg8::EpiF32N{proj, 3088, 3088});
            mlstm_naive<<<8, 128, 0, stream>>>(proj, mlstm_conv_w, mlstm_gate_b, mlstm_norm_w, mix);
            cvt_bf16<<<L * D / 2048, 256, 0, stream>>>(mix, A2);
            convert_w(stream, mlstm_w_out, D, D, D, D, WB, 0);
            launch_gemm(stream, A2, WB, L, D, D, pg8::EpiF32N{hbuf, D, D});
        } else {
            convert_w(stream, s5_w_in, D, D, D, D, WB, 0);
            launch_gemm(stream, A1, WB, L, D, D, pg8::EpiF32N{proj, D, D});
            s5_naive<<<64, 64, 0, stream>>>(proj, s5_a_re, s5_a_im, s5_log_dt, s5_b_re, s5_b_im, s5_c_re, s5_c_im, s5_d, mix);
            cvt_bf16<<<L * D / 2048, 256, 0, stream>>>(mix, A2);
            convert_w(stream, s5_w_out, D, 2048, 2048, 2048, WB, 0);
            launch_gemm(stream, A2, WB, L, 2048, D, pg8::EpiF32N{zbuf, 2048, 2048});
            glu_kernel<<<(L * D) / 256, 256, 0, stream>>>(zbuf, hbuf5);
            hb = hbuf5;
        }
        ln_res<<<L / 4, 256, 0, stream>>>(xc, hb, out, ln_g + (i * 2 + 0) * D, ln_b + (i * 2 + 0) * D);
        xc = out;
        cvt_bf16<<<L * D / 2048, 256, 0, stream>>>(xc, A2);
        convert_w(stream, ffn_w_gate_up + (size_t)i * D * 2 * FF, D, 2 * FF, 2 * FF, 2 * FF, WB, FF);
        launch_gemm(stream, A2, WB, L, 2 * FF, D, pg8::EpiGateUp{Hff, FF, 0});
        convert_w(stream, ffn_w_down + (size_t)i * FF * D, FF, D, D, D, WB, 0);
        launch_gemm(stream, Hff, WB, L, D, FF, pg8::EpiF32N{dn, D, D});
        ln_res<<<L / 4, 256, 0, stream>>>(xc, dn, out, ln_g + (i * 2 + 1) * D, ln_b + (i * 2 + 1) * D);
    }
}
```

```cpp
#include <hip/hip_runtime.h>
#include <cstdint>
#include <cstdio>

constexpr int L = 16384, D = 1024, FF = 2816;
constexpr float ALPHA = 1.681792830507429f;
constexpr float LN_EPS = 1e-5f, HN_EPS = 1e-6f;

__device__ __forceinline__ float sigmoidf_(float x) { return 1.f / (1.f + __expf(-x)); }
__device__ __forceinline__ float siluf_(float x) { return x * sigmoidf_(x); }
__device__ __forceinline__ float logsigmoidf_(float x) { return fminf(x, 0.f) - log1pf(expf(-fabsf(x))); }
__device__ __forceinline__ float gelu_tanh_(float x) { return 0.5f * x * (1.f + tanhf(0.7978845608028654f * (x + 0.044715f * x * x * x))); }
namespace pg8 {
#define PG8_LAS __attribute__((address_space(3)))
typedef unsigned short bf16_t;
typedef short bf16x8 __attribute__((ext_vector_type(8)));
typedef float f32x4 __attribute__((ext_vector_type(4)));
typedef unsigned u32x4 __attribute__((ext_vector_type(4)));
constexpr int BM = 256, BK = 64, HALF = 128, HTB = HALF * BK * 2  , STAGE_BYTES = 8 * HTB, NXCD = 8, WGM = 8;

__host__ __device__ __forceinline__ int lds_byte(int r, int c) { const int st = (r >> 4) * 2 + (c >> 5), rr = r & 15, cc = c & 31, ob = rr * 64 + cc * 2; return st * 1024 + (ob ^ (((ob >> 9) & 1) << 5)); }
__host__ __device__ __forceinline__ void stage_rc(int b, int& R, int& C) { const int st = b / 1024, sb = b % 1024, swz = sb ^ (((sb >> 9) & 1) << 5); R = (st >> 1) * 16 + swz / 64; C = (st & 1) * 32 + (swz % 64) / 2; }
__host__ __device__ __forceinline__ int perm32(int rho) { const int n = rho >> 4, i = rho & 15; return 8 * (i >> 2) + 4 * n + (i & 3); }

struct Unit { int pm, pn; };
struct Gemm { const bf16_t* A; const bf16_t* Bt; int M, N, K, pad; };

struct StaticOrder {
    int nM, nN, nwg, G, c;
    __host__ __device__ void init(int M, int N, int G_, int c_) { nM = M / BM; nN = N / BM; nwg = nM * nN; G = G_; c = c_; }
    __host__ __device__ bool next(int i, Unit& u) const {
        const long L = (long)i * G + c; if (L >= nwg) return false;
        int wgid = (int)L; { const int q = nwg / NXCD, r = nwg % NXCD, xcd = wgid % NXCD, off = wgid / NXCD; wgid = (xcd < r ? xcd * (q + 1) : r * (q + 1) + (xcd - r) * q) + off; }
        const int nig = WGM * nN, gid = wgid / nig, fm = gid * WGM, gsz = (nM - fm) < WGM ? (nM - fm) : WGM;
        u.pm = fm + ((wgid % nig) % gsz); u.pn = (wgid % nig) / gsz; return true;
    }
    __device__ __forceinline__ void a_ready(const Unit&) const {}
    __device__ __forceinline__ void done(const Unit&) const {}
};

__device__ __forceinline__ unsigned cvt_pk_bf16(float lo, float hi) { unsigned r; asm volatile("v_cvt_pk_bf16_f32 %0, %1, %2" : "=v"(r) : "v"(lo), "v"(hi)); return r; }
typedef float f32x2 __attribute__((ext_vector_type(2)));
struct PanelStats {
    unsigned* xbuf;
    unsigned* cnt;
    unsigned* tmo;
    int ntn; float eps;
    unsigned code;
    __device__ __forceinline__ bool run(const f32x4 (&v)[2][2][4][2], const Unit& u, int wr, int wc, int fr, int fq, PG8_LAS unsigned char* lds, int wid, int lane) const {
        typedef float f32x2v __attribute__((ext_vector_type(2)));
        PG8_LAS f32x2v* P = (PG8_LAS f32x2v*)lds;
        PG8_LAS f32x2v* S = (PG8_LAS f32x2v*)(lds + 8192);
        PG8_LAS unsigned* flag = (PG8_LAS unsigned*)(lds + 8192 + 2048);
#pragma unroll
        for (int ai = 0; ai < 2; ++ai)
#pragma unroll
            for (int m = 0; m < 4; ++m) {
                float s = 0.f;
#pragma unroll
                for (int bj = 0; bj < 2; ++bj)
#pragma unroll
                    for (int n = 0; n < 2; ++n) { const f32x4 x = v[ai][bj][m][n]; s += (x[0] + x[1]) + (x[2] + x[3]); }
                s += __shfl_xor(s, 16); s += __shfl_xor(s, 32);
                const float mw = s * (1.0f / 64.0f); float q = 0.f;
#pragma unroll
                for (int bj = 0; bj < 2; ++bj)
#pragma unroll
                    for (int n = 0; n < 2; ++n) { const f32x4 d = v[ai][bj][m][n] - mw; q += (d[0] * d[0] + d[1] * d[1]) + (d[2] * d[2] + d[3] * d[3]); }
                q += __shfl_xor(q, 16); q += __shfl_xor(q, 32);
                if (fq == 0) P[(ai * HALF + wr * 64 + m * 16 + fr) * 4 + wc] = (f32x2v){mw, q};
            }
        asm volatile("s_waitcnt lgkmcnt(0)" ::: "memory"); __builtin_amdgcn_s_barrier(); asm volatile("" ::: "memory");
#if defined(BROKEN_EXCHANGE_NO_WAIT)
#warning BROKEN CONTROL BUILD: the row-statistics exchange does not wait; results are wrong by design
        if (blockIdx.x >= 64) { const long long t0_ = clock64(); while (clock64() - t0_ < 60000) __builtin_amdgcn_s_sleep(8); }
#endif
        const int row = wid * 32 + (lane & 31);
        if (lane < 32) {
            const f32x2v a = P[row * 4 + 0], b = P[row * 4 + 1], c = P[row * 4 + 2], d = P[row * 4 + 3];
            const float mt = (a.x + b.x + c.x + d.x) * 0.25f;
            const float da = a.x - mt, db = b.x - mt, dc = c.x - mt, dd = d.x - mt;
            const float m2 = (a.y + b.y) + (c.y + d.y) + 64.0f * ((da * da + db * db) + (dc * dc + dd * dd));
            unsigned long long* slot = (unsigned long long*)xbuf + ((size_t)(u.pm * BM + row) * 4 + u.pn);
            __hip_atomic_store(slot, ((unsigned long long)__float_as_uint(m2) << 32) | __float_as_uint(mt), __ATOMIC_RELAXED, __HIP_MEMORY_SCOPE_AGENT);
        }
        asm volatile("s_waitcnt vmcnt(0)" ::: "memory");
        if (lane == 0) __hip_atomic_fetch_add(cnt + 64 * u.pm, 1u, __ATOMIC_RELAXED, __HIP_MEMORY_SCOPE_AGENT);
        if (wid == 0) {
            bool dead = false; const unsigned long long t0 = __builtin_amdgcn_s_memrealtime(); const unsigned want = 8u * (unsigned)ntn;
            for (;;) {
#if defined(BROKEN_EXCHANGE_NO_WAIT)
                break;
#endif
                if ((unsigned)__builtin_amdgcn_readfirstlane(__hip_atomic_load(cnt + 64 * u.pm, __ATOMIC_RELAXED, __HIP_MEMORY_SCOPE_AGENT)) >= want) break;
                if (__builtin_amdgcn_s_memrealtime() - t0 > 2000000ull) {
                    if (lane == 0) { unsigned expect = 0u; __hip_atomic_compare_exchange_strong(tmo + 1, &expect, code | (unsigned)(u.pm & 0xff), __ATOMIC_RELAXED, __ATOMIC_RELAXED, __HIP_MEMORY_SCOPE_AGENT);
                                     __hip_atomic_store(tmo, 1u, __ATOMIC_RELAXED, __HIP_MEMORY_SCOPE_AGENT); }
                    dead = true; break; }
                __builtin_amdgcn_s_sleep(2);
            }
            __builtin_amdgcn_fence(__ATOMIC_ACQUIRE, "agent");
            if (lane == 0) flag[0] = dead ? 1u : 0u;
        }
        asm volatile("s_waitcnt vmcnt(0) lgkmcnt(0)" ::: "memory"); __builtin_amdgcn_s_barrier(); asm volatile("" ::: "memory");
        const bool bad = flag[0] != 0u;
        if (lane < 32) {
            const unsigned long long* slot = (const unsigned long long*)xbuf + (size_t)(u.pm * BM + row) * 4; float mt[4], m2[4]; float ms = 0.f;
#pragma unroll
            for (int t = 0; t < 4; ++t) { if (t < ntn) { const unsigned long long w = __hip_atomic_load(slot + t, __ATOMIC_RELAXED, __HIP_MEMORY_SCOPE_AGENT); mt[t] = __uint_as_float((unsigned)w); m2[t] = __uint_as_float((unsigned)(w >> 32)); } else { mt[t] = 0.f; m2[t] = 0.f; } ms += mt[t]; }
            const float mean = ms / (float)ntn; float q = 0.f;
#pragma unroll
            for (int t = 0; t < 4; ++t) if (t < ntn) { const float dm = mt[t] - mean; q += m2[t] + 256.0f * dm * dm; }
            S[row] = (f32x2v){mean, 1.0f / sqrtf(q / (256.0f * (float)ntn) + eps)};
        }
        asm volatile("s_waitcnt lgkmcnt(0)" ::: "memory"); __builtin_amdgcn_s_barrier(); asm volatile("" ::: "memory");
        return bad;
    }
};
struct EpiF32N {
    static constexpr bool PERM = false, AFTER_DRAIN = false;
    float* C; int ldc; int nvalid;
    __device__ __forceinline__ void operator()(const f32x4 (&acc)[2][2][4][2], const Unit& u, int wr, int wc, int fr, int fq) const {
        const int row0 = u.pm * BM + wr * 64 + fr, col0 = u.pn * BM + wc * 32 + 4 * fq;
#pragma unroll
        for (int ai = 0; ai < 2; ++ai)
#pragma unroll
            for (int m = 0; m < 4; ++m) { float* rowp = C + (size_t)(row0 + ai * HALF + m * 16) * ldc;
#pragma unroll
                for (int bj = 0; bj < 2; ++bj)
#pragma unroll
                    for (int n = 0; n < 2; ++n) { const int c = col0 + bj * HALF + n * 16; if (c < nvalid) *(f32x4*)(rowp + c) = acc[ai][bj][m][n]; } }
    }
};
typedef unsigned u32x2 __attribute__((ext_vector_type(2)));
__device__ __forceinline__ float silu_f(float x) { return x / (1.f + __expf(-x)); }
struct EpiGateUp {
    static constexpr bool PERM = false, AFTER_DRAIN = false;
    bf16_t* Hh; int ldc, pad;
    __device__ __forceinline__ void operator()(const f32x4 (&acc)[2][2][4][2], const Unit& u, int wr, int wc, int fr, int fq) const {
        const int row0 = u.pm * BM + wr * 64 + fr, col0 = u.pn * HALF + wc * 32 + 4 * fq;
#pragma unroll
        for (int ai = 0; ai < 2; ++ai)
#pragma unroll
            for (int m = 0; m < 4; ++m) { bf16_t* rowp = Hh + (size_t)(row0 + ai * HALF + m * 16) * ldc + col0;
#pragma unroll
                for (int n = 0; n < 2; ++n) { const f32x4 g = acc[ai][0][m][n], up = acc[ai][1][m][n];
                    u32x2 w; w.x = cvt_pk_bf16(silu_f(g[0]) * up[0], silu_f(g[1]) * up[1]); w.y = cvt_pk_bf16(silu_f(g[2]) * up[2], silu_f(g[3]) * up[3]);
                    *(u32x2*)(rowp + n * 16) = w; } }
    }
};
struct EpiSplit {
    static constexpr bool PERM = false, AFTER_DRAIN = false;
    void* dst[4]; int act[4]; const float* lb;
    __device__ __forceinline__ void operator()(const f32x4 (&acc)[2][2][4][2], const Unit& u, int wr, int wc, int fr, int fq) const {
        const int kind = u.pn >> 2, a = act[kind];
        const int row0 = u.pm * BM + wr * 64 + fr, col0 = (u.pn & 3) * BM + wc * 32 + 4 * fq;
        if (a == 3) {
            float* base = (float*)dst[kind];
#pragma unroll
            for (int bj = 0; bj < 2; ++bj)
#pragma unroll
                for (int n = 0; n < 2; ++n) { const int c = col0 + bj * HALF + n * 16; const f32x4 lbv = *(const f32x4*)(lb + c);
#pragma unroll
                    for (int ai = 0; ai < 2; ++ai)
#pragma unroll
                        for (int m = 0; m < 4; ++m) { const f32x4 v = acc[ai][bj][m][n]; f32x4 o;
#pragma unroll
                            for (int j = 0; j < 4; ++j) { const float sg = 1.f / (1.f + __expf(-v[j])); o[j] = __logf(lbv[j] + (1.f - lbv[j]) * sg); }
                            *(f32x4*)(base + (size_t)(row0 + ai * HALF + m * 16) * 1024 + c) = o; } }
        } else {
            bf16_t* base = (bf16_t*)dst[kind];
#pragma unroll
            for (int ai = 0; ai < 2; ++ai)
#pragma unroll
                for (int m = 0; m < 4; ++m) { bf16_t* rowp = base + (size_t)(row0 + ai * HALF + m * 16) * 1024 + col0;
#pragma unroll
                    for (int bj = 0; bj < 2; ++bj)
#pragma unroll
                        for (int n = 0; n < 2; ++n) { f32x4 v = acc[ai][bj][m][n];
                            if (a == 1) { v[0] = silu_f(v[0]); v[1] = silu_f(v[1]); v[2] = silu_f(v[2]); v[3] = silu_f(v[3]); }
                            else if (a == 2) { v[0] = 1.f / (1.f + __expf(-v[0])); v[1] = 1.f / (1.f + __expf(-v[1])); v[2] = 1.f / (1.f + __expf(-v[2])); v[3] = 1.f / (1.f + __expf(-v[3])); }
                            u32x2 w; w.x = cvt_pk_bf16(v[0], v[1]); w.y = cvt_pk_bf16(v[2], v[3]);
                            *(u32x2*)(rowp + bj * HALF + n * 16) = w; } }
        }
    }
};
template <class Epi, class Sched, bool ALIGN_EPI = false, bool SP2 = false>
__device__ __forceinline__ void gemm_phase(PG8_LAS unsigned char* lds, const Gemm g, const Sched& S, const Epi& E) {
    const int tid = threadIdx.x, wid = __builtin_amdgcn_readfirstlane(tid >> 6), lane = tid & 63, wr = wid >> 2, wc = wid & 3, fr = lane & 15, fq = lane >> 4;
    const int K = g.K, nt = K / BK;
    unsigned voffA[2], voffB[2];
#pragma unroll
    for (int i = 0; i < 2; ++i) { int R, C; stage_rc(tid * 16 + i * 8192, R, C); const int Rb = Epi::PERM ? ((R & ~31) + perm32(R & 31)) : R;
        voffA[i] = (unsigned)(R * K + C) * 2u; voffB[i] = (unsigned)(Rb * K + C) * 2u; }
    const size_t kstep = (size_t)(BK * 2);
    const size_t hstep = (size_t)HALF * K * 2;
    const size_t tstep = 2 * hstep;
    const unsigned ldsw = (unsigned)wid * 1024u;
    const int aoff = lds_byte(wr * 64 + fr, fq * 8), boff = lds_byte(wc * 32 + fr, fq * 8);
#define PG8_SA(b, h) (((b) * 2 + (h)) * HTB)
#define PG8_SB(b, h) ((4 + (b) * 2 + (h)) * HTB)
#define PG8_STAGE(bufoff, gbase, voff) do { _Pragma("unroll") for (int _i = 0; _i < 2; ++_i) \
        __builtin_amdgcn_global_load_lds((const unsigned*)((const char*)(gbase) + (voff)[_i]), (PG8_LAS unsigned*)(lds + (bufoff) + ldsw + _i * 8192), 16, 0, 0); } while (0)
#define PG8_LDA(dst, b, h) do { _Pragma("unroll") for (int m = 0; m < 4; ++m) _Pragma("unroll") for (int k = 0; k < 2; ++k) dst[m][k] = *(const PG8_LAS bf16x8*)(lds + PG8_SA(b, h) + aoff + m * 2048 + k * 1024); } while (0)
#define PG8_LDB(dst, b, h) do { _Pragma("unroll") for (int n = 0; n < 2; ++n) _Pragma("unroll") for (int k = 0; k < 2; ++k) dst[n][k] = *(const PG8_LAS bf16x8*)(lds + PG8_SB(b, h) + boff + n * 2048 + k * 1024); } while (0)
#define PG8_MMA(ai, bj, At, Bt) do { __builtin_amdgcn_s_setprio(1); _Pragma("unroll") for (int m = 0; m < 4; ++m) _Pragma("unroll") for (int n = 0; n < 2; ++n) _Pragma("unroll") for (int k = 0; k < 2; ++k) \
        acc[ai][bj][m][n] = __builtin_amdgcn_mfma_f32_16x16x32_bf16(Bt[n][k], At[m][k], acc[ai][bj][m][n], 0, 0, 0); __builtin_amdgcn_s_setprio(0); } while (0)
#define PG8_WAIT_V(n) asm volatile("s_waitcnt vmcnt(" #n ")" ::: "memory")
#define PG8_WAIT_L(n) asm volatile("s_waitcnt lgkmcnt(" #n ")" ::: "memory")
#define PG8_BAR __builtin_amdgcn_s_barrier()
#define PG8_SCHED __builtin_amdgcn_sched_barrier(0)
    Unit cur, nxt; int ui = 0;
    if (!S.next(0, cur)) return;
    f32x4 acc[2][2][4][2];
#pragma unroll
    for (int a = 0; a < 2; ++a)
#pragma unroll
        for (int b = 0; b < 2; ++b)
#pragma unroll
            for (int m = 0; m < 4; ++m)
#pragma unroll
                for (int n = 0; n < 2; ++n) acc[a][b][m][n] = (f32x4){0.f, 0.f, 0.f, 0.f};
    bf16x8 At[4][2], B0[2][2], B1[2][2];
    const char* cA = (const char*)g.A + (size_t)cur.pm * tstep; const char* cB = (const char*)g.Bt + (size_t)cur.pn * tstep;
    S.a_ready(cur);
    if constexpr (SP2) {
        PG8_STAGE(PG8_SB(0, 0), cB, voffB); PG8_STAGE(PG8_SB(0, 1), cB + hstep, voffB); PG8_STAGE(PG8_SA(0, 0), cA, voffA); PG8_STAGE(PG8_SA(0, 1), cA + hstep, voffA);
        if (wr == 1) PG8_BAR;
        PG8_WAIT_V(2); PG8_BAR;
        PG8_STAGE(PG8_SB(1, 0), cB + kstep, voffB); PG8_STAGE(PG8_SA(1, 0), cA + kstep, voffA); PG8_STAGE(PG8_SB(1, 1), cB + hstep + kstep, voffB);
        PG8_WAIT_V(6); PG8_BAR;
    } else {
        PG8_STAGE(PG8_SB(0, 0), cB, voffB); PG8_STAGE(PG8_SA(0, 0), cA, voffA); PG8_STAGE(PG8_SB(0, 1), cB + hstep, voffB); PG8_STAGE(PG8_SA(0, 1), cA + hstep, voffA);
        if (wr == 1) PG8_BAR;
        PG8_WAIT_V(4); PG8_BAR;
        PG8_STAGE(PG8_SB(1, 0), cB + kstep, voffB); PG8_STAGE(PG8_SA(1, 0), cA + kstep, voffA); PG8_STAGE(PG8_SB(1, 1), cB + hstep + kstep, voffB);
        PG8_WAIT_V(6); PG8_BAR;
    }
    for (;;) {
        const bool has_next = S.next(ui + 1, nxt);
        const char* nA = has_next ? (const char*)g.A + (size_t)nxt.pm * tstep : cA; const char* nB = has_next ? (const char*)g.Bt + (size_t)nxt.pn * tstep : cB;
        for (int t = 0; t < nt; t += 2) {
            const bool last = (t == nt - 2);
            const char* a1 = cA + (size_t)(t + 1) * kstep;
            const char* a2 = last ? nA : cA + (size_t)(t + 2) * kstep; const char* b2 = last ? nB : cB + (size_t)(t + 2) * kstep;
            const char* a3 = a2 + kstep; const char* b3 = b2 + kstep;
            if (last && has_next) S.a_ready(nxt);
            if constexpr (SP2) {
            PG8_LDB(B0, 0, 0); PG8_LDB(B1, 0, 1); PG8_SCHED; PG8_LDA(At, 0, 0); PG8_STAGE(PG8_SA(1, 1), a1 + hstep, voffA);
            PG8_WAIT_V(8); PG8_WAIT_L(0); PG8_BAR; PG8_MMA(0, 0, At, B0); PG8_MMA(0, 1, At, B1); PG8_BAR; PG8_SCHED;
            PG8_LDA(At, 0, 1); PG8_STAGE(PG8_SB(0, 0), b2, voffB); PG8_STAGE(PG8_SB(0, 1), b2 + hstep, voffB); PG8_STAGE(PG8_SA(0, 0), a2, voffA);
            PG8_WAIT_V(8); PG8_WAIT_L(0); PG8_BAR; PG8_MMA(1, 0, At, B0); PG8_MMA(1, 1, At, B1); PG8_BAR; PG8_SCHED;
            PG8_LDB(B0, 1, 0); PG8_LDB(B1, 1, 1); PG8_SCHED; PG8_LDA(At, 1, 0); PG8_STAGE(PG8_SA(0, 1), a2 + hstep, voffA);
            PG8_WAIT_V(8); PG8_WAIT_L(0); PG8_BAR; PG8_MMA(0, 0, At, B0); PG8_MMA(0, 1, At, B1); PG8_BAR; PG8_SCHED;
            PG8_LDA(At, 1, 1); PG8_STAGE(PG8_SB(1, 0), b3, voffB); PG8_STAGE(PG8_SB(1, 1), b3 + hstep, voffB); PG8_STAGE(PG8_SA(1, 0), a3, voffA);
            PG8_WAIT_V(8); PG8_WAIT_L(0); PG8_BAR; PG8_MMA(1, 0, At, B0); PG8_MMA(1, 1, At, B1); PG8_BAR; PG8_SCHED;
            } else {
            PG8_LDB(B0, 0, 0); PG8_SCHED; PG8_LDA(At, 0, 0); PG8_STAGE(PG8_SA(1, 1), a1 + hstep, voffA);
            PG8_WAIT_L(8); PG8_BAR; PG8_WAIT_L(0); PG8_MMA(0, 0, At, B0); PG8_BAR; PG8_SCHED;
            PG8_LDB(B1, 0, 1); PG8_STAGE(PG8_SB(0, 0), b2, voffB);
            PG8_BAR; PG8_WAIT_L(0); PG8_MMA(0, 1, At, B1); PG8_BAR;
            PG8_LDA(At, 0, 1); PG8_STAGE(PG8_SA(0, 0), a2, voffA);
            PG8_BAR; PG8_WAIT_L(0); PG8_MMA(1, 0, At, B0); PG8_BAR; PG8_SCHED;
            PG8_STAGE(PG8_SB(0, 1), b2 + hstep, voffB);
            PG8_WAIT_V(6); PG8_BAR; PG8_MMA(1, 1, At, B1); PG8_BAR;
            PG8_LDB(B0, 1, 0); PG8_SCHED; PG8_LDA(At, 1, 0); PG8_STAGE(PG8_SA(0, 1), a2 + hstep, voffA);
            PG8_WAIT_L(8); PG8_BAR; PG8_WAIT_L(0); PG8_MMA(0, 0, At, B0); PG8_BAR; PG8_SCHED;
            PG8_LDB(B1, 1, 1); PG8_STAGE(PG8_SB(1, 0), b3, voffB);
            PG8_BAR; PG8_WAIT_L(0); PG8_MMA(0, 1, At, B1); PG8_BAR;
            PG8_LDA(At, 1, 1); PG8_STAGE(PG8_SA(1, 0), a3, voffA);
            PG8_BAR; PG8_WAIT_L(0); PG8_MMA(1, 0, At, B0); PG8_BAR; PG8_SCHED;
            PG8_STAGE(PG8_SB(1, 1), b3 + hstep, voffB);
            PG8_WAIT_V(6); PG8_BAR; PG8_MMA(1, 1, At, B1); PG8_BAR;
            }
        }
        if constexpr (ALIGN_EPI) { if (wr == 0) PG8_BAR; }
        if constexpr (!Epi::AFTER_DRAIN) { E(acc, cur, wr, wc, fr, fq); S.done(cur); }
        if (!has_next) break;
#pragma unroll
        for (int a = 0; a < 2; ++a)
#pragma unroll
            for (int b = 0; b < 2; ++b)
#pragma unroll
                for (int m = 0; m < 4; ++m)
#pragma unroll
                    for (int n = 0; n < 2; ++n) acc[a][b][m][n] = (f32x4){0.f, 0.f, 0.f, 0.f};
        cur = nxt; cA = nA; cB = nB; ++ui;
        if constexpr (ALIGN_EPI) { if (wr == 1) PG8_BAR; }
    }
    PG8_WAIT_V(0);
    if constexpr (!ALIGN_EPI) { if (wr == 0) PG8_BAR; }
    PG8_BAR;
    if constexpr (Epi::AFTER_DRAIN) { E.fused(acc, cur, wr, wc, fr, fq, lds, wid, lane); S.done(cur); }
#undef PG8_SA
#undef PG8_SB
#undef PG8_STAGE
#undef PG8_LDA
#undef PG8_LDB
#undef PG8_MMA
#undef PG8_WAIT_V
#undef PG8_WAIT_L
#undef PG8_BAR
#undef PG8_SCHED
}
}
namespace mx {
typedef unsigned char uchar;
typedef unsigned short bf16_t;
typedef short bf16x8 __attribute__((ext_vector_type(8)));
typedef float f32x4 __attribute__((ext_vector_type(4)));
typedef unsigned u32x4 __attribute__((ext_vector_type(4)));
typedef unsigned u32x2 __attribute__((ext_vector_type(2)));
#define MXL __attribute__((address_space(3)))
__device__ __forceinline__ unsigned f2bf(float f) { unsigned u = __builtin_bit_cast(unsigned, f); return (u + 0x7fffu + ((u >> 16) & 1u)) >> 16; }
__device__ __forceinline__ unsigned pk2(float lo, float hi) { return f2bf(lo) | (f2bf(hi) << 16); }
__device__ __forceinline__ float bf2f(unsigned h) { return __builtin_bit_cast(float, h << 16); }
__device__ __forceinline__ bf16x8 ldfrag(const MXL uchar* p) { return *(const MXL bf16x8*)p; }
__device__ __forceinline__ f32x4 mma(bf16x8 a, bf16x8 b, f32x4 c) { return __builtin_amdgcn_mfma_f32_16x16x32_bf16(a, b, c, 0, 0, 0); }

struct HgrnP { const bf16_t* Q; const float* LF; const bf16_t* V; const bf16_t* G; bf16_t* ST; float* DEC; bf16_t* O; const float* norm_w; };

__device__ __forceinline__ void vt_issue(const bf16_t* V, size_t rowbase, int col0, int tid, u32x4& v0, u32x4& v1) {
    const bf16_t* vp = V + (rowbase + (tid & 63)) * 1024 + col0 + (tid >> 6) * 16; v0 = *(const u32x4*)vp; v1 = *(const u32x4*)(vp + 8);
}
__device__ __forceinline__ void vt_write(MXL bf16_t* VT, int tid, const u32x4& v0, const u32x4& v1) {
    const int s = tid & 63, e0 = (tid >> 6) * 16;
#pragma unroll
    for (int j = 0; j < 4; ++j) { VT[(e0 + 2 * j) * 72 + s] = (bf16_t)(v0[j] & 0xffffu); VT[(e0 + 2 * j + 1) * 72 + s] = (bf16_t)(v0[j] >> 16);
                                  VT[(e0 + 8 + 2 * j) * 72 + s] = (bf16_t)(v1[j] & 0xffffu); VT[(e0 + 8 + 2 * j + 1) * 72 + s] = (bf16_t)(v1[j] >> 16); }
}

__device__ __forceinline__ void hgrn_p2a(MXL uchar* lds, const HgrnP& p) {
    const int tid = threadIdx.x, lane = tid & 63, wid = tid >> 6, d = tid & 127, qt = tid >> 7, fr = lane & 15, fq = lane >> 4;
    MXL uchar* KD = lds; MXL uchar* VTb = lds + 18432; MXL float* QS = (MXL float*)(lds + 36864);
    for (int unit = blockIdx.x; unit < 2048; unit += gridDim.x) {
        const int c = unit >> 3, h = unit & 7; const size_t rowbase = (size_t)c * 64;
        float b[16], k[16];
        { const float* lfp = p.LF + (rowbase + qt * 16) * 1024 + h * 128 + d;
#pragma unroll
          for (int i = 0; i < 16; ++i) b[i] = lfp[(size_t)i * 1024]; }
        u32x4 v0, v1; vt_issue(p.V, rowbase, h * 128, tid, v0, v1);
#pragma unroll
        for (int i = 0; i < 16; ++i) k[i] = 1.f - __expf(b[i]);
#pragma unroll
        for (int i = 1; i < 16; ++i) b[i] += b[i - 1];
        QS[qt * 128 + d] = b[15];
        vt_write((MXL bf16_t*)VTb, tid, v0, v1);
        __syncthreads();
        float off = 0.f, tot = 0.f;
#pragma unroll
        for (int q = 0; q < 4; ++q) { const float x = QS[q * 128 + d]; off += q < qt ? x : 0.f; tot += x; }
        { u32x4 o0, o1; float kd[16];
#pragma unroll
          for (int i = 0; i < 16; ++i) kd[i] = k[i] * __expf(tot - (b[i] + off));
          o0.x = pk2(kd[0], kd[1]); o0.y = pk2(kd[2], kd[3]); o0.z = pk2(kd[4], kd[5]); o0.w = pk2(kd[6], kd[7]);
          o1.x = pk2(kd[8], kd[9]); o1.y = pk2(kd[10], kd[11]); o1.z = pk2(kd[12], kd[13]); o1.w = pk2(kd[14], kd[15]);
          MXL u32x4* dst = (MXL u32x4*)(KD + d * 144 + qt * 32); dst[0] = o0; dst[1] = o1; }
        if (qt == 0) p.DEC[(size_t)unit * 128 + d] = __expf(tot);
        __syncthreads();
        {
            const bf16x8 bv0 = ldfrag(VTb + (wid * 16 + fr) * 144 + fq * 16), bv1 = ldfrag(VTb + (wid * 16 + fr) * 144 + 64 + fq * 16);
            bf16_t* st = p.ST + (size_t)unit * 16384 + (wid * 16 + fr) * 128 + 4 * fq;
#pragma unroll
            for (int dt = 0; dt < 8; ++dt) {
                f32x4 acc = {0.f, 0.f, 0.f, 0.f};
                acc = mma(ldfrag(KD + (dt * 16 + fr) * 144 + fq * 16), bv0, acc);
                acc = mma(ldfrag(KD + (dt * 16 + fr) * 144 + 64 + fq * 16), bv1, acc);
                u32x2 w; w.x = pk2(acc[0], acc[1]); w.y = pk2(acc[2], acc[3]);
                *(u32x2*)(st + dt * 16) = w;
            }
        }
        __syncthreads();
    }
}

__device__ __forceinline__ void hgrn_p2b(const HgrnP& p) {
    for (int pid = blockIdx.x * 512 + threadIdx.x; pid < 65536; pid += gridDim.x * 512) {
        const int h = pid >> 13, idx2 = (pid & 8191) * 2, d = idx2 & 127;
        float S0 = 0.f, S1 = 0.f;
        for (int c0 = 0; c0 < 256; c0 += 16) {
            unsigned u[16]; float2 a[16];
#pragma unroll
            for (int i = 0; i < 16; ++i) { const size_t unit = (size_t)(c0 + i) * 8 + h; u[i] = *(const unsigned*)(p.ST + unit * 16384 + idx2); a[i] = *(const float2*)(p.DEC + unit * 128 + d); }
#pragma unroll
            for (int i = 0; i < 16; ++i) { const size_t unit = (size_t)(c0 + i) * 8 + h;
                *(unsigned*)(p.ST + unit * 16384 + idx2) = pk2(S0, S1);
                S0 = a[i].x * S0 + bf2f(u[i] & 0xffffu); S1 = a[i].y * S1 + bf2f(u[i] >> 16); }
        }
    }
}

__device__ __forceinline__ void hgrn_p2c(MXL uchar* lds, const HgrnP& p) {
    const int tid = threadIdx.x, lane = tid & 63, wid = tid >> 6, d = tid & 127, qt = tid >> 7, fr = lane & 15, fq = lane >> 4;
    MXL uchar* QT = lds; MXL uchar* KT = lds + 17408; MXL uchar* QE = lds + 34816; MXL uchar* VTb = lds + 52224; MXL uchar* STI = lds + 70656; MXL uchar* ATT = lds + 105472;
    MXL float* QS = (MXL float*)(lds + 114688); MXL float* BMID = (MXL float*)(lds + 116736); MXL float* RED = (MXL float*)(lds + 117248);
    for (int unit = blockIdx.x; unit < 2048; unit += gridDim.x) {
        const int c = unit >> 3, h = unit & 7; const size_t rowbase = (size_t)c * 64;
        float b[16], k[16]; unsigned short qraw[16];
        { const float* lfp = p.LF + (rowbase + qt * 16) * 1024 + h * 128 + d; const bf16_t* qp = p.Q + (rowbase + qt * 16) * 1024 + h * 128 + d;
#pragma unroll
          for (int i = 0; i < 16; ++i) { b[i] = lfp[(size_t)i * 1024]; qraw[i] = qp[(size_t)i * 1024]; } }
        u32x4 v0, v1; vt_issue(p.V, rowbase, h * 128, tid, v0, v1);
        u32x4 sv[4];
        { const bf16_t* sp = p.ST + (size_t)unit * 16384;
#pragma unroll
          for (int i = 0; i < 4; ++i) sv[i] = *(const u32x4*)(sp + (size_t)(tid + 512 * i) * 8); }
#pragma unroll
        for (int i = 0; i < 16; ++i) k[i] = 1.f - __expf(b[i]);
#pragma unroll
        for (int i = 1; i < 16; ++i) b[i] += b[i - 1];
        QS[qt * 128 + d] = b[15];
        vt_write((MXL bf16_t*)VTb, tid, v0, v1);
#pragma unroll
        for (int i = 0; i < 4; ++i) { const int id = tid + 512 * i, e = id >> 4, ch = id & 15; *(MXL u32x4*)(STI + e * 272 + ch * 16) = sv[i]; }
        __syncthreads();
        float off = 0.f;
#pragma unroll
        for (int q = 0; q < 4; ++q) { const float x = QS[q * 128 + d]; off += q < qt ? x : 0.f; }
#pragma unroll
        for (int i = 0; i < 16; ++i) b[i] += off;
        if (qt == 1) BMID[d] = b[15];
        __syncthreads();
        { const float bm = BMID[d];
#pragma unroll
          for (int i = 0; i < 16; ++i) { const int t = qt * 16 + i; const float e1 = __expf(b[i] - bm), qf = bf2f(qraw[i]);
              ((MXL bf16_t*)QT)[t * 136 + d] = (bf16_t)f2bf(qf * e1); ((MXL bf16_t*)KT)[t * 136 + d] = (bf16_t)f2bf(k[i] / e1); ((MXL bf16_t*)QE)[t * 136 + d] = (bf16_t)f2bf(qf * __expf(b[i])); } }
        __syncthreads();
        {
            const int tt = wid >> 1;
            bf16x8 qf[4];
#pragma unroll
            for (int ks = 0; ks < 4; ++ks) qf[ks] = ldfrag(QT + (tt * 16 + fr) * 272 + ks * 64 + fq * 16);
#pragma unroll
            for (int j = 0; j < 2; ++j) { const int sti = (wid & 1) * 2 + j; f32x4 acc = {0.f, 0.f, 0.f, 0.f};
                if (sti <= tt) {
#pragma unroll
                    for (int ks = 0; ks < 4; ++ks) acc = mma(ldfrag(KT + (sti * 16 + fr) * 272 + ks * 64 + fq * 16), qf[ks], acc);
                }
                const int t = tt * 16 + fr, s0 = sti * 16 + 4 * fq;
                float a0 = (s0 + 0 <= t) ? acc[0] : 0.f, a1 = (s0 + 1 <= t) ? acc[1] : 0.f, a2 = (s0 + 2 <= t) ? acc[2] : 0.f, a3 = (s0 + 3 <= t) ? acc[3] : 0.f;
                if (sti > tt) { a0 = 0.f; a1 = 0.f; a2 = 0.f; a3 = 0.f; }
                u32x2 w; w.x = pk2(a0, a1); w.y = pk2(a2, a3);
                *(MXL u32x2*)(ATT + t * 144 + s0 * 2) = w; }
        }
        __syncthreads();
        {
            const int tt = wid & 3, eh = wid >> 2, t = tt * 16 + fr;
            bf16x8 af[2], qe[4];
#pragma unroll
            for (int ks = 0; ks < 2; ++ks) af[ks] = ldfrag(ATT + t * 144 + ks * 64 + fq * 16);
#pragma unroll
            for (int ks = 0; ks < 4; ++ks) qe[ks] = ldfrag(QE + t * 272 + ks * 64 + fq * 16);
            f32x4 acc[4]; float ss = 0.f;
#pragma unroll
            for (int et = 0; et < 4; ++et) { const int er = eh * 64 + et * 16 + fr; f32x4 a = {0.f, 0.f, 0.f, 0.f};
#pragma unroll
                for (int ks = 0; ks < 2; ++ks) a = mma(ldfrag(VTb + er * 144 + ks * 64 + fq * 16), af[ks], a);
#pragma unroll
                for (int ks = 0; ks < 4; ++ks) a = mma(ldfrag(STI + er * 272 + ks * 64 + fq * 16), qe[ks], a);
                acc[et] = a; ss += (a[0] * a[0] + a[1] * a[1]) + (a[2] * a[2] + a[3] * a[3]); }
            ss += __shfl_xor(ss, 16); ss += __shfl_xor(ss, 32);
            if (lane < 16) RED[eh * 64 + t] = ss;
            __syncthreads();
            const float r = rsqrtf((RED[t] + RED[64 + t]) * (1.f / 128.f) + HN_EPS);
#pragma unroll
            for (int et = 0; et < 4; ++et) { const int e0 = eh * 64 + et * 16 + 4 * fq; const size_t go = (rowbase + t) * 1024 + h * 128 + e0;
                const u32x2 g = *(const u32x2*)(p.G + go); const f32x4 nw = *(const f32x4*)(p.norm_w + e0);
                u32x2 w; w.x = pk2(acc[et][0] * r * nw[0] * bf2f(g.x & 0xffffu), acc[et][1] * r * nw[1] * bf2f(g.x >> 16));
                w.y = pk2(acc[et][2] * r * nw[2] * bf2f(g.y & 0xffffu), acc[et][3] * r * nw[3] * bf2f(g.y >> 16));
                *(u32x2*)(p.O + go) = w; }
        }
        __syncthreads();
    }
}
}
using pg8::bf16_t;
#define LAS __attribute__((address_space(3)))
__device__ __forceinline__ unsigned f2bf(float f) { unsigned u = __builtin_bit_cast(unsigned, f); return (u + 0x7fffu + ((u >> 16) & 1u)) >> 16; }
__device__ __forceinline__ unsigned pk2(float lo, float hi) { return f2bf(lo) | (f2bf(hi) << 16); }
typedef unsigned v4u __attribute__((ext_vector_type(4)));

template <class Epi>
__global__ void __launch_bounds__(512, 2) gemm_kernel(pg8::Gemm g, Epi E) {
    extern __shared__ __attribute__((aligned(16))) unsigned char lds[];
    pg8::StaticOrder S; S.init(g.M, g.N, (int)gridDim.x, (int)blockIdx.x);
    pg8::gemm_phase<Epi, pg8::StaticOrder, true, true>((LAS unsigned char*)lds, g, S, E);
}

__global__ void __launch_bounds__(256) wt_convert(const float* __restrict__ src, int K, int ldsrc, int nsrc, bf16_t* __restrict__ dst, int half) {
    __shared__ float tile[64][65];
    const int n0 = blockIdx.x * 64, k0 = blockIdx.y * 64, tid = threadIdx.x;
    for (int i = 0; i < 16; ++i) { const int e = tid + 256 * i, kk = e >> 6, nn = e & 63, n = n0 + nn;
        int col; bool ok;
        if (half == 0) { col = n; ok = n < nsrc; } else { const int t = n >> 8, w = n & 255; col = (w < 128 ? 0 : half) + t * 128 + (w & 127); ok = true; }
        tile[kk][nn] = ok ? src[(size_t)(k0 + kk) * ldsrc + col] : 0.f; }
    __syncthreads();
    const int nn = tid >> 2, kq = tid & 3;
    v4u o0, o1;
    o0.x = pk2(tile[kq * 16 + 0][nn], tile[kq * 16 + 1][nn]); o0.y = pk2(tile[kq * 16 + 2][nn], tile[kq * 16 + 3][nn]); o0.z = pk2(tile[kq * 16 + 4][nn], tile[kq * 16 + 5][nn]); o0.w = pk2(tile[kq * 16 + 6][nn], tile[kq * 16 + 7][nn]);
    o1.x = pk2(tile[kq * 16 + 8][nn], tile[kq * 16 + 9][nn]); o1.y = pk2(tile[kq * 16 + 10][nn], tile[kq * 16 + 11][nn]); o1.z = pk2(tile[kq * 16 + 12][nn], tile[kq * 16 + 13][nn]); o1.w = pk2(tile[kq * 16 + 14][nn], tile[kq * 16 + 15][nn]);
    v4u* d = (v4u*)(dst + (size_t)(n0 + nn) * K + k0 + kq * 16);
    d[0] = o0; d[1] = o1;
}
__global__ void __launch_bounds__(256) cvt_bf16(const float* __restrict__ src, bf16_t* __restrict__ dst) {
    const size_t i = ((size_t)blockIdx.x * 256 + threadIdx.x) * 8;
    const float4 a = *(const float4*)(src + i), b = *(const float4*)(src + i + 4);
    v4u o; o.x = pk2(a.x, a.y); o.y = pk2(a.z, a.w); o.z = pk2(b.x, b.y); o.w = pk2(b.z, b.w);
    *(v4u*)(dst + i) = o;
}

__global__ void __launch_bounds__(256) ln_res(const float* xin, const float* h, float* xout, const float* __restrict__ g, const float* __restrict__ b) {
    const int row = blockIdx.x * 4 + (threadIdx.x >> 6), lane = threadIdx.x & 63;
    float v[16]; float s = 0.f;
    for (int j = 0; j < 16; ++j) { const int c = lane + 64 * j; v[j] = ALPHA * xin[(size_t)row * D + c] + h[(size_t)row * D + c]; s += v[j]; }
    for (int o = 1; o < 64; o <<= 1) s += __shfl_xor(s, o);
    const float mean = s * (1.f / D); float q = 0.f;
    for (int j = 0; j < 16; ++j) { v[j] -= mean; q += v[j] * v[j]; }
    for (int o = 1; o < 64; o <<= 1) q += __shfl_xor(q, o);
    const float rstd = rsqrtf(q * (1.f / D) + LN_EPS);
    for (int j = 0; j < 16; ++j) { const int c = lane + 64 * j; xout[(size_t)row * D + c] = v[j] * rstd * g[c] + b[c]; }
}

__global__ void hgrn_lb_kernel(const float* __restrict__ logits, float* __restrict__ lb  ) {
    const int c = blockIdx.x * blockDim.x + threadIdx.x; if (c >= D) return;
    float l[4], mx = -1e30f; for (int i = 0; i < 4; ++i) { l[i] = logits[i * D + c]; mx = fmaxf(mx, l[i]); }
    float e[4], s = 0.f; for (int i = 0; i < 4; ++i) { e[i] = expf(l[i] - mx); s += e[i]; }
    float cs = 0.f, c0 = 0.f; for (int i = 0; i < 4; ++i) { cs += e[i] / s; if (i == 0) c0 = cs; lb[i * D + c] = cs - c0; }
}

__global__ void __launch_bounds__(128) hgrn_naive(const float* __restrict__ proj  , const float* __restrict__ lbv  , const float* __restrict__ norm_w  , float* __restrict__ mix  ) {
    __shared__ float sq[128], sf[128], sk[128], red[2];
    const int h = blockIdx.x, e = threadIdx.x, col = h * 128 + e;
    float S[128];
#pragma unroll
    for (int d = 0; d < 128; ++d) S[d] = 0.f;
    const float lb = lbv[col], nw = norm_w[e];
    for (int t = 0; t < L; ++t) {
        const float* pr = proj + (size_t)t * 4096;
        const float qr = pr[col], fr = pr[1024 + col], v = pr[2048 + col], gr = pr[3072 + col];
        const float sg = sigmoidf_(fr);
        const float ft = lb + (1.f - lb) * sg;
        const float kt = (1.f - lb) * sigmoidf_(-fr);
        sq[e] = siluf_(qr); sf[e] = ft; sk[e] = kt;
        __syncthreads();
        float o = 0.f;
#pragma unroll
        for (int d = 0; d < 128; ++d) { S[d] = sf[d] * S[d] + sk[d] * v; o += sq[d] * S[d]; }
        float ss = o * o;
        for (int off = 1; off < 64; off <<= 1) ss += __shfl_xor(ss, off);
        if ((e & 63) == 0) red[e >> 6] = ss;
        __syncthreads();
        const float tot = red[0] + red[1];
        mix[(size_t)t * D + col] = o * rsqrtf(tot * (1.f / 128.f) + HN_EPS) * nw * siluf_(gr);
        __syncthreads();
    }
}

__global__ void __launch_bounds__(128) mlstm_naive(const float* __restrict__ proj  , const float* __restrict__ conv_w  , const float* __restrict__ gate_b  ,
                                                   const float* __restrict__ norm_w  , float* __restrict__ mix) {
    __shared__ float sq[64], sk[64], red[2];
    const int h = blockIdx.x, e = threadIdx.x;
    constexpr int W = 3088;
    const int cch = e < 64 ? h * 64 + e : 512 + h * 64 + (e - 64);
    const float cw0 = conv_w[cch], cw1 = conv_w[1024 + cch], cw2 = conv_w[2048 + cch], cw3 = conv_w[3072 + cch];
    float p0 = 0.f, p1 = 0.f, p2 = 0.f;
    float C[64], n[64];
#pragma unroll
    for (int d = 0; d < 64; ++d) { C[d] = 0.f; n[d] = 0.f; }
    const float bi = gate_b[h], bf = gate_b[8 + h], nw = norm_w[h * 128 + e];
    for (int t = 0; t < L; ++t) {
        const float* pr = proj + (size_t)t * W;
        const float u = pr[cch];
        float cv = cw0 * p0 + cw1 * p1 + cw2 * p2 + cw3 * u; p0 = p1; p1 = p2; p2 = u;
        cv = siluf_(cv);
        if (e < 64) sq[e] = cv; else sk[e - 64] = cv * 0.125f;
        const float v = pr[1024 + h * 128 + e], op = pr[2048 + h * 128 + e];
        const float gi = pr[3072 + h] + bi, gf = pr[3080 + h] + bf;
        const float it = expf(gi), ft = sigmoidf_(gf);
        __syncthreads();
        float num = 0.f, den = 0.f;
#pragma unroll
        for (int d = 0; d < 64; ++d) { const float kk = it * sk[d]; C[d] = ft * C[d] + kk * v; n[d] = ft * n[d] + kk; num += sq[d] * C[d]; den += sq[d] * n[d]; }
        const float hh = num / fmaxf(fabsf(den), 1.f);
        float ss = hh * hh;
        for (int off = 1; off < 64; off <<= 1) ss += __shfl_xor(ss, off);
        if ((e & 63) == 0) red[e >> 6] = ss;
        __syncthreads();
        const float tot = red[0] + red[1];
        mix[(size_t)t * D + h * 128 + e] = hh * rsqrtf(tot * (1.f / 128.f) + HN_EPS) * nw * sigmoidf_(op);
        __syncthreads();
    }
}

__global__ void __launch_bounds__(64) s5_naive(const float* __restrict__ u  , const float* __restrict__ a_re, const float* __restrict__ a_im, const float* __restrict__ log_dt,
                                               const float* __restrict__ b_re, const float* __restrict__ b_im, const float* __restrict__ c_re, const float* __restrict__ c_im,
                                               const float* __restrict__ dsk, float* __restrict__ mix) {
    __shared__ float ssr[64], ssi[64];
    const int g = blockIdx.x, p = threadIdx.x;
    const float dt = expf(log_dt[g]);
    const float ar = a_re[g * 64 + p], ai = a_im[g * 64 + p];
    const float mag = expf(ar * dt);
    const float abr = mag * cosf(ai * dt), abi = mag * sinf(ai * dt);
    const float nr = abr - 1.f, ni = abi, den = ar * ar + ai * ai;
    const float cr = (nr * ar + ni * ai) / den, ci = (ni * ar - nr * ai) / den;
    float bbr[16], bbi[16];
    for (int c = 0; c < 16; ++c) { const float br = b_re[(g * 64 + p) * 16 + c], bim = b_im[(g * 64 + p) * 16 + c]; bbr[c] = cr * br - ci * bim; bbi[c] = cr * bim + ci * br; }
    const int oc = p & 15, oq = p >> 4;
    float ccr[16], cci[16];
    for (int j = 0; j < 16; ++j) { ccr[j] = c_re[(g * 16 + oc) * 64 + oq * 16 + j]; cci[j] = c_im[(g * 16 + oc) * 64 + oq * 16 + j]; }
    const float dk = dsk[g * 16 + oc];
    float sr = 0.f, si = 0.f;
    for (int t = 0; t < L; ++t) {
        const float* ur = u + (size_t)t * D + g * 16;
        float br = 0.f, bi = 0.f;
#pragma unroll
        for (int c = 0; c < 16; ++c) { const float uu = ur[c]; br += bbr[c] * uu; bi += bbi[c] * uu; }
        const float nsr = abr * sr - abi * si + br, nsi = abr * si + abi * sr + bi; sr = nsr; si = nsi;
        ssr[p] = sr; ssi[p] = si;
        __syncthreads();
        float y = 0.f;
#pragma unroll
        for (int j = 0; j < 16; ++j) y += ssr[oq * 16 + j] * ccr[j] - ssi[oq * 16 + j] * cci[j];
        y += __shfl_xor(y, 16); y += __shfl_xor(y, 32);
        if (oq == 0) { y += dk * ur[oc]; mix[(size_t)t * D + g * 16 + oc] = gelu_tanh_(y); }
        __syncthreads();
    }
}

__global__ void glu_kernel(const float* __restrict__ z, float* __restrict__ h) {
    const size_t i = (size_t)blockIdx.x * blockDim.x + threadIdx.x; const size_t m = i / D, c = i % D;
    h[i] = z[m * 2048 + c] * sigmoidf_(z[m * 2048 + 1024 + c]);
}


#define MXL __attribute__((address_space(3)))
constexpr int MIX_LDS = 122880;
template <int PH> __global__ void __launch_bounds__(512, 2) hgrn_kernel(mx::HgrnP p) {
    extern __shared__ __attribute__((aligned(16))) unsigned char lds[];
    if (PH == 0) mx::hgrn_p2a((MXL unsigned char*)lds, p); else if (PH == 1) mx::hgrn_p2b(p); else mx::hgrn_p2c((MXL unsigned char*)lds, p);
}
template <int PH> static void launch_hgrn(hipStream_t st, const mx::HgrnP& p) {
    static bool init = false;
    if (!init) { (void)hipFuncSetAttribute((const void*)hgrn_kernel<PH>, hipFuncAttributeMaxDynamicSharedMemorySize, MIX_LDS); init = true; }
    hipLaunchKernelGGL(hgrn_kernel<PH>, dim3(256), dim3(512), MIX_LDS, st, p);
}

constexpr int GEMM_LDS = 131072;
template <class Epi> static void launch_gemm(hipStream_t st, const bf16_t* A, const bf16_t* Bt, int M, int N, int K, Epi E) {
    static bool init = false;
    if (!init) { (void)hipFuncSetAttribute((const void*)gemm_kernel<Epi>, hipFuncAttributeMaxDynamicSharedMemorySize, GEMM_LDS); init = true; }
    pg8::Gemm g{A, Bt, M, N, K, 0};
    hipLaunchKernelGGL(gemm_kernel<Epi>, dim3(256), dim3(512), GEMM_LDS, st, g, E);
}
static void convert_w(hipStream_t st, const float* src, int K, int ldsrc, int nsrc, int Npad, bf16_t* dst, int half) {
    wt_convert<<<dim3(Npad / 64, K / 64), 256, 0, st>>>(src, K, ldsrc, nsrc, dst, half);
}

extern "C" void kernel_launch(void* const* d_in, const int* in_sizes, int n_in, void* d_out, int out_size, void* d_ws, size_t ws_size, hipStream_t stream) {
    const float* x = (const float*)d_in[0];
    const float* hgrn_w_in = (const float*)d_in[1]; const float* hgrn_norm_w = (const float*)d_in[2]; const float* hgrn_w_out = (const float*)d_in[3]; const float* hgrn_lb_logits = (const float*)d_in[4];
    const float* mlstm_w_in = (const float*)d_in[5]; const float* mlstm_conv_w = (const float*)d_in[6]; const float* mlstm_gate_b = (const float*)d_in[7]; const float* mlstm_norm_w = (const float*)d_in[8]; const float* mlstm_w_out = (const float*)d_in[9];
    const float* s5_w_in = (const float*)d_in[10]; const float* s5_a_re = (const float*)d_in[11]; const float* s5_a_im = (const float*)d_in[12]; const float* s5_log_dt = (const float*)d_in[13];
    const float* s5_b_re = (const float*)d_in[14]; const float* s5_b_im = (const float*)d_in[15]; const float* s5_c_re = (const float*)d_in[16]; const float* s5_c_im = (const float*)d_in[17];
    const float* s5_d = (const float*)d_in[18]; const float* s5_w_out = (const float*)d_in[19];
    const float* ffn_w_gate_up = (const float*)d_in[20]; const float* ffn_w_down = (const float*)d_in[21]; const float* ln_g = (const float*)d_in[22]; const float* ln_b = (const float*)d_in[23];
    float* out = (float*)d_out;
    char* ws = (char*)d_ws;
    const size_t MiB = 1u << 20;
    if (ws_size < 344 * MiB) { fprintf(stderr, "ws too small: %zu\n", ws_size); return; }
    bf16_t* WB = (bf16_t*)(ws);
    float* proj = (float*)(ws + 16 * MiB);
    float* mix = (float*)(ws + 272 * MiB);
    bf16_t* A1 = (bf16_t*)(ws + 276 * MiB);
    bf16_t* A2 = (bf16_t*)(ws + 80 * MiB);
    float* hbuf = (float*)(ws + 16 * MiB);
    float* zbuf = (float*)(ws + 112 * MiB);
    float* hbuf5 = (float*)(ws + 16 * MiB);
    bf16_t* Hff = (bf16_t*)(ws + 112 * MiB);
    float* dn = (float*)(ws + 200 * MiB);
    float* lb = (float*)(ws + 340 * MiB);

    hgrn_lb_kernel<<<4, 256, 0, stream>>>(hgrn_lb_logits, lb);
    const float* xc = x;
    for (int i = 0; i < 4; ++i) {
        const int kind = i % 3, j = i / 3;
        cvt_bf16<<<L * D / 2048, 256, 0, stream>>>(xc, A1);
        float* hb = hbuf;
        if (kind == 0) {
            convert_w(stream, hgrn_w_in + (size_t)j * D * 4096, D, 4096, 4096, 4096, WB, 0);
            bf16_t* Qb = (bf16_t*)(ws + 16 * MiB); float* LFb = (float*)(ws + 48 * MiB); bf16_t* Vb = (bf16_t*)(ws + 112 * MiB); bf16_t* Gb = (bf16_t*)(ws + 144 * MiB);
            bf16_t* STb = (bf16_t*)(ws + 176 * MiB); float* DECb = (float*)(ws + 240 * MiB); bf16_t* Ob = (bf16_t*)(ws + 244 * MiB);
            pg8::EpiSplit E{}; E.dst[0] = Qb; E.dst[1] = LFb; E.dst[2] = Vb; E.dst[3] = Gb; E.act[0] = 1; E.act[1] = 3; E.act[2] = 0; E.act[3] = 1; E.lb = lb + i * D;
            launch_gemm(stream, A1, WB, L, 4096, D, E);
            mx::HgrnP hp{Qb, LFb, Vb, Gb, STb, DECb, Ob, hgrn_norm_w + j * 128};
            launch_hgrn<0>(stream, hp); launch_hgrn<1>(stream, hp); launch_hgrn<2>(stream, hp);
            convert_w(stream, hgrn_w_out + (size_t)j * D * D, D, D, D, D, WB, 0);
            launch_gemm(stream, Ob, WB, L, D, D, pg8::EpiF32N{hbuf, D, D});
        } else if (kind == 1) {
            convert_w(stream, mlstm_w_in, D, 3088, 3088, 3328, WB, 0);
            launch_gemm(stream, A1, WB, L, 3328, D, pg8::EpiF32N{proj, 3088, 3088});
            mlstm_naive<<<8, 128, 0, stream>>>(proj, mlstm_conv_w, mlstm_gate_b, mlstm_norm_w, mix);
            cvt_bf16<<<L * D / 2048, 256, 0, stream>>>(mix, A2);
            convert_w(stream, mlstm_w_out, D, D, D, D, WB, 0);
            launch_gemm(stream, A2, WB, L, D, D, pg8::EpiF32N{hbuf, D, D});
        } else {
            convert_w(stream, s5_w_in, D, D, D, D, WB, 0);
            launch_gemm(stream, A1, WB, L, D, D, pg8::EpiF32N{proj, D, D});
            s5_naive<<<64, 64, 0, stream>>>(proj, s5_a_re, s5_a_im, s5_log_dt, s5_b_re, s5_b_im, s5_c_re, s5_c_im, s5_d, mix);
            cvt_bf16<<<L * D / 2048, 256, 0, stream>>>(mix, A2);
            convert_w(stream, s5_w_out, D, 2048, 2048, 2048, WB, 0);
            launch_gemm(stream, A2, WB, L, 2048, D, pg8::EpiF32N{zbuf, 2048, 2048});
            glu_kernel<<<(L * D) / 256, 256, 0, stream>>>(zbuf, hbuf5);
            hb = hbuf5;
        }
        ln_res<<<L / 4, 256, 0, stream>>>(xc, hb, out, ln_g + (i * 2 + 0) * D, ln_b + (i * 2 + 0) * D);
        xc = out;
        cvt_bf16<<<L * D / 2048, 256, 0, stream>>>(xc, A2);
        convert_w(stream, ffn_w_gate_up + (size_t)i * D * 2 * FF, D, 2 * FF, 2 * FF, 2 * FF, WB, FF);
        launch_gemm(stream, A2, WB, L, 2 * FF, D, pg8::EpiGateUp{Hff, FF, 0});
        convert_w(stream, ffn_w_down + (size_t)i * FF * D, FF, D, D, D, WB, 0);
        launch_gemm(stream, Hff, WB, L, D, FF, pg8::EpiF32N{dn, D, D});
        ln_res<<<L / 4, 256, 0, stream>>>(xc, dn, out, ln_g + (i * 2 + 1) * D, ln_b + (i * 2 + 1) * D);
    }
}
```

```cpp
#include <hip/hip_runtime.h>
#include <cstdint>
#include <cstdio>

constexpr int L = 16384, D = 1024, FF = 2816;
constexpr float ALPHA = 1.681792830507429f;
constexpr float LN_EPS = 1e-5f, HN_EPS = 1e-6f;

__device__ __forceinline__ float sigmoidf_(float x) { return 1.f / (1.f + __expf(-x)); }
__device__ __forceinline__ float siluf_(float x) { return x * sigmoidf_(x); }
__device__ __forceinline__ float logsigmoidf_(float x) { return fminf(x, 0.f) - log1pf(expf(-fabsf(x))); }
__device__ __forceinline__ float gelu_tanh_(float x) { return 0.5f * x * (1.f + tanhf(0.7978845608028654f * (x + 0.044715f * x * x * x))); }
namespace pg8 {
#define PG8_LAS __attribute__((address_space(3)))
typedef unsigned short bf16_t;
typedef short bf16x8 __attribute__((ext_vector_type(8)));
typedef float f32x4 __attribute__((ext_vector_type(4)));
typedef unsigned u32x4 __attribute__((ext_vector_type(4)));
constexpr int BM = 256, BK = 64, HALF = 128, HTB = HALF * BK * 2  , STAGE_BYTES = 8 * HTB, NXCD = 8, WGM = 8;

__host__ __device__ __forceinline__ int lds_byte(int r, int c) { const int st = (r >> 4) * 2 + (c >> 5), rr = r & 15, cc = c & 31, ob = rr * 64 + cc * 2; return st * 1024 + (ob ^ (((ob >> 9) & 1) << 5)); }
__host__ __device__ __forceinline__ void stage_rc(int b, int& R, int& C) { const int st = b / 1024, sb = b % 1024, swz = sb ^ (((sb >> 9) & 1) << 5); R = (st >> 1) * 16 + swz / 64; C = (st & 1) * 32 + (swz % 64) / 2; }
__host__ __device__ __forceinline__ int perm32(int rho) { const int n = rho >> 4, i = rho & 15; return 8 * (i >> 2) + 4 * n + (i & 3); }

struct Unit { int pm, pn; };
struct Gemm { const bf16_t* A; const bf16_t* Bt; int M, N, K, pad; };

struct StaticOrder {
    int nM, nN, nwg, G, c;
    __host__ __device__ void init(int M, int N, int G_, int c_) { nM = M / BM; nN = N / BM; nwg = nM * nN; G = G_; c = c_; }
    __host__ __device__ bool next(int i, Unit& u) const {
        const long L = (long)i * G + c; if (L >= nwg) return false;
        int wgid = (int)L; { const int q = nwg / NXCD, r = nwg % NXCD, xcd = wgid % NXCD, off = wgid / NXCD; wgid = (xcd < r ? xcd * (q + 1) : r * (q + 1) + (xcd - r) * q) + off; }
        const int nig = WGM * nN, gid = wgid / nig, fm = gid * WGM, gsz = (nM - fm) < WGM ? (nM - fm) : WGM;
        u.pm = fm + ((wgid % nig) % gsz); u.pn = (wgid % nig) / gsz; return true;
    }
    __device__ __forceinline__ void a_ready(const Unit&) const {}
    __device__ __forceinline__ void done(const Unit&) const {}
};

__device__ __forceinline__ unsigned cvt_pk_bf16(float lo, float hi) { unsigned r; asm volatile("v_cvt_pk_bf16_f32 %0, %1, %2" : "=v"(r) : "v"(lo), "v"(hi)); return r; }
typedef float f32x2 __attribute__((ext_vector_type(2)));
struct PanelStats {
    unsigned* xbuf;
    unsigned* cnt;
    unsigned* tmo;
    int ntn; float eps;
    unsigned code;
    __device__ __forceinline__ bool run(const f32x4 (&v)[2][2][4][2], const Unit& u, int wr, int wc, int fr, int fq, PG8_LAS unsigned char* lds, int wid, int lane) const {
        typedef float f32x2v __attribute__((ext_vector_type(2)));
        PG8_LAS f32x2v* P = (PG8_LAS f32x2v*)lds;
        PG8_LAS f32x2v* S = (PG8_LAS f32x2v*)(lds + 8192);
        PG8_LAS unsigned* flag = (PG8_LAS unsigned*)(lds + 8192 + 2048);
#pragma unroll
        for (int ai = 0; ai < 2; ++ai)
#pragma unroll
            for (int m = 0; m < 4; ++m) {
                float s = 0.f;
#pragma unroll
                for (int bj = 0; bj < 2; ++bj)
#pragma unroll
                    for (int n = 0; n < 2; ++n) { const f32x4 x = v[ai][bj][m][n]; s += (x[0] + x[1]) + (x[2] + x[3]); }
                s += __shfl_xor(s, 16); s += __shfl_xor(s, 32);
                const float mw = s * (1.0f / 64.0f); float q = 0.f;
#pragma unroll
                for (int bj = 0; bj < 2; ++bj)
#pragma unroll
                    for (int n = 0; n < 2; ++n) { const f32x4 d = v[ai][bj][m][n] - mw; q += (d[0] * d[0] + d[1] * d[1]) + (d[2] * d[2] + d[3] * d[3]); }
                q += __shfl_xor(q, 16); q += __shfl_xor(q, 32);
                if (fq == 0) P[(ai * HALF + wr * 64 + m * 16 + fr) * 4 + wc] = (f32x2v){mw, q};
            }
        asm volatile("s_waitcnt lgkmcnt(0)" ::: "memory"); __builtin_amdgcn_s_barrier(); asm volatile("" ::: "memory");
#if defined(BROKEN_EXCHANGE_NO_WAIT)
#warning BROKEN CONTROL BUILD: the row-statistics exchange does not wait; results are wrong by design
        if (blockIdx.x >= 64) { const long long t0_ = clock64(); while (clock64() - t0_ < 60000) __builtin_amdgcn_s_sleep(8); }
#endif
        const int row = wid * 32 + (lane & 31);
        if (lane < 32) {
            const f32x2v a = P[row * 4 + 0], b = P[row * 4 + 1], c = P[row * 4 + 2], d = P[row * 4 + 3];
            const float mt = (a.x + b.x + c.x + d.x) * 0.25f;
            const float da = a.x - mt, db = b.x - mt, dc = c.x - mt, dd = d.x - mt;
            const float m2 = (a.y + b.y) + (c.y + d.y) + 64.0f * ((da * da + db * db) + (dc * dc + dd * dd));
            unsigned long long* slot = (unsigned long long*)xbuf + ((size_t)(u.pm * BM + row) * 4 + u.pn);
            __hip_atomic_store(slot, ((unsigned long long)__float_as_uint(m2) << 32) | __float_as_uint(mt), __ATOMIC_RELAXED, __HIP_MEMORY_SCOPE_AGENT);
        }
        asm volatile("s_waitcnt vmcnt(0)" ::: "memory");
        if (lane == 0) __hip_atomic_fetch_add(cnt + 64 * u.pm, 1u, __ATOMIC_RELAXED, __HIP_MEMORY_SCOPE_AGENT);
        if (wid == 0) {
            bool dead = false; const unsigned long long t0 = __builtin_amdgcn_s_memrealtime(); const unsigned want = 8u * (unsigned)ntn;
            for (;;) {
#if defined(BROKEN_EXCHANGE_NO_WAIT)
                break;
#endif
                if ((unsigned)__builtin_amdgcn_readfirstlane(__hip_atomic_load(cnt + 64 * u.pm, __ATOMIC_RELAXED, __HIP_MEMORY_SCOPE_AGENT)) >= want) break;
                if (__builtin_amdgcn_s_memrealtime() - t0 > 2000000ull) {
                    if (lane == 0) { unsigned expect = 0u; __hip_atomic_compare_exchange_strong(tmo + 1, &expect, code | (unsigned)(u.pm & 0xff), __ATOMIC_RELAXED, __ATOMIC_RELAXED, __HIP_MEMORY_SCOPE_AGENT);
                                     __hip_atomic_store(tmo, 1u, __ATOMIC_RELAXED, __HIP_MEMORY_SCOPE_AGENT); }
                    dead = true; break; }
                __builtin_amdgcn_s_sleep(2);
            }
            __builtin_amdgcn_fence(__ATOMIC_ACQUIRE, "agent");
            if (lane == 0) flag[0] = dead ? 1u : 0u;
        }
        asm volatile("s_waitcnt vmcnt(0) lgkmcnt(0)" ::: "memory"); __builtin_amdgcn_s_barrier(); asm volatile("" ::: "memory");
        const bool bad = flag[0] != 0u;
        if (lane < 32) {
            const unsigned long long* slot = (const unsigned long long*)xbuf + (size_t)(u.pm * BM + row) * 4; float mt[4], m2[4]; float ms = 0.f;
#pragma unroll
            for (int t = 0; t < 4; ++t) { if (t < ntn) { const unsigned long long w = __hip_atomic_load(slot + t, __ATOMIC_RELAXED, __HIP_MEMORY_SCOPE_AGENT); mt[t] = __uint_as_float((unsigned)w); m2[t] = __uint_as_float((unsigned)(w >> 32)); } else { mt[t] = 0.f; m2[t] = 0.f; } ms += mt[t]; }
            const float mean = ms / (float)ntn; float q = 0.f;
#pragma unroll
            for (int t = 0; t < 4; ++t) if (t < ntn) { const float dm = mt[t] - mean; q += m2[t] + 256.0f * dm * dm; }
            S[row] = (f32x2v){mean, 1.0f / sqrtf(q / (256.0f * (float)ntn) + eps)};
        }
        asm volatile("s_waitcnt lgkmcnt(0)" ::: "memory"); __builtin_amdgcn_s_barrier(); asm volatile("" ::: "memory");
        return bad;
    }
};
struct EpiF32N {
    static constexpr bool PERM = false, AFTER_DRAIN = false;
    float* C; int ldc; int nvalid;
    __device__ __forceinline__ void operator()(const f32x4 (&acc)[2][2][4][2], const Unit& u, int wr, int wc, int fr, int fq) const {
        const int row0 = u.pm * BM + wr * 64 + fr, col0 = u.pn * BM + wc * 32 + 4 * fq;
#pragma unroll
        for (int ai = 0; ai < 2; ++ai)
#pragma unroll
            for (int m = 0; m < 4; ++m) { float* rowp = C + (size_t)(row0 + ai * HALF + m * 16) * ldc;
#pragma unroll
                for (int bj = 0; bj < 2; ++bj)
#pragma unroll
                    for (int n = 0; n < 2; ++n) { const int c = col0 + bj * HALF + n * 16; if (c < nvalid) *(f32x4*)(rowp + c) = acc[ai][bj][m][n]; } }
    }
};
typedef unsigned u32x2 __attribute__((ext_vector_type(2)));
__device__ __forceinline__ float silu_f(float x) { return x / (1.f + __expf(-x)); }
struct EpiGateUp {
    static constexpr bool PERM = false, AFTER_DRAIN = false;
    bf16_t* Hh; int ldc, pad;
    __device__ __forceinline__ void operator()(const f32x4 (&acc)[2][2][4][2], const Unit& u, int wr, int wc, int fr, int fq) const {
        const int row0 = u.pm * BM + wr * 64 + fr, col0 = u.pn * HALF + wc * 32 + 4 * fq;
#pragma unroll
        for (int ai = 0; ai < 2; ++ai)
#pragma unroll
            for (int m = 0; m < 4; ++m) { bf16_t* rowp = Hh + (size_t)(row0 + ai * HALF + m * 16) * ldc + col0;
#pragma unroll
                for (int n = 0; n < 2; ++n) { const f32x4 g = acc[ai][0][m][n], up = acc[ai][1][m][n];
                    u32x2 w; w.x = cvt_pk_bf16(silu_f(g[0]) * up[0], silu_f(g[1]) * up[1]); w.y = cvt_pk_bf16(silu_f(g[2]) * up[2], silu_f(g[3]) * up[3]);
                    *(u32x2*)(rowp + n * 16) = w; } }
    }
};
struct EpiSplit {
    static constexpr bool PERM = false, AFTER_DRAIN = false;
    void* dst[4]; int act[4]; const float* lb;
    __device__ __forceinline__ void operator()(const f32x4 (&acc)[2][2][4][2], const Unit& u, int wr, int wc, int fr, int fq) const {
        const int kind = u.pn >> 2, a = act[kind];
        const int row0 = u.pm * BM + wr * 64 + fr, col0 = (u.pn & 3) * BM + wc * 32 + 4 * fq;
        if (a == 3) {
            float* base = (float*)dst[kind];
#pragma unroll
            for (int bj = 0; bj < 2; ++bj)
#pragma unroll
                for (int n = 0; n < 2; ++n) { const int c = col0 + bj * HALF + n * 16; const f32x4 lbv = *(const f32x4*)(lb + c);
#pragma unroll
                    for (int ai = 0; ai < 2; ++ai)
#pragma unroll
                        for (int m = 0; m < 4; ++m) { const f32x4 v = acc[ai][bj][m][n]; f32x4 o;
#pragma unroll
                            for (int j = 0; j < 4; ++j) { const float sg = 1.f / (1.f + __expf(-v[j])); o[j] = __logf(lbv[j] + (1.f - lbv[j]) * sg); }
                            *(f32x4*)(base + (size_t)(row0 + ai * HALF + m * 16) * 1024 + c) = o; } }
        } else {
            bf16_t* base = (bf16_t*)dst[kind];
#pragma unroll
            for (int ai = 0; ai < 2; ++ai)
#pragma unroll
                for (int m = 0; m < 4; ++m) { bf16_t* rowp = base + (size_t)(row0 + ai * HALF + m * 16) * 1024 + col0;
#pragma unroll
                    for (int bj = 0; bj < 2; ++bj)
#pragma unroll
                        for (int n = 0; n < 2; ++n) { f32x4 v = acc[ai][bj][m][n];
                            if (a == 1) { v[0] = silu_f(v[0]); v[1] = silu_f(v[1]); v[2] = silu_f(v[2]); v[3] = silu_f(v[3]); }
                            else if (a == 2) { v[0] = 1.f / (1.f + __expf(-v[0])); v[1] = 1.f / (1.f + __expf(-v[1])); v[2] = 1.f / (1.f + __expf(-v[2])); v[3] = 1.f / (1.f + __expf(-v[3])); }
                            u32x2 w; w.x = cvt_pk_bf16(v[0], v[1]); w.y = cvt_pk_bf16(v[2], v[3]);
                            *(u32x2*)(rowp + bj * HALF + n * 16) = w; } }
        }
    }
};
template <class Epi, class Sched, bool ALIGN_EPI = false, bool SP2 = false>
__device__ __forceinline__ void gemm_phase(PG8_LAS unsigned char* lds, const Gemm g, const Sched& S, const Epi& E) {
    const int tid = threadIdx.x, wid = __builtin_amdgcn_readfirstlane(tid >> 6), lane = tid & 63, wr = wid >> 2, wc = wid & 3, fr = lane & 15, fq = lane >> 4;
    const int K = g.K, nt = K / BK;
    unsigned voffA[2], voffB[2];
#pragma unroll
    for (int i = 0; i < 2; ++i) { int R, C; stage_rc(tid * 16 + i * 8192, R, C); const int Rb = Epi::PERM ? ((R & ~31) + perm32(R & 31)) : R;
        voffA[i] = (unsigned)(R * K + C) * 2u; voffB[i] = (unsigned)(Rb * K + C) * 2u; }
    const size_t kstep = (size_t)(BK * 2);
    const size_t hstep = (size_t)HALF * K * 2;
    const size_t tstep = 2 * hstep;
    const unsigned ldsw = (unsigned)wid * 1024u;
    const int aoff = lds_byte(wr * 64 + fr, fq * 8), boff = lds_byte(wc * 32 + fr, fq * 8);
#define PG8_SA(b, h) (((b) * 2 + (h)) * HTB)
#define PG8_SB(b, h) ((4 + (b) * 2 + (h)) * HTB)
#define PG8_STAGE(bufoff, gbase, voff) do { _Pragma("unroll") for (int _i = 0; _i < 2; ++_i) \
        __builtin_amdgcn_global_load_lds((const unsigned*)((const char*)(gbase) + (voff)[_i]), (PG8_LAS unsigned*)(lds + (bufoff) + ldsw + _i * 8192), 16, 0, 0); } while (0)
#define PG8_LDA(dst, b, h) do { _Pragma("unroll") for (int m = 0; m < 4; ++m) _Pragma("unroll") for (int k = 0; k < 2; ++k) dst[m][k] = *(const PG8_LAS bf16x8*)(lds + PG8_SA(b, h) + aoff + m * 2048 + k * 1024); } while (0)
#define PG8_LDB(dst, b, h) do { _Pragma("unroll") for (int n = 0; n < 2; ++n) _Pragma("unroll") for (int k = 0; k < 2; ++k) dst[n][k] = *(const PG8_LAS bf16x8*)(lds + PG8_SB(b, h) + boff + n * 2048 + k * 1024); } while (0)
#define PG8_MMA(ai, bj, At, Bt) do { __builtin_amdgcn_s_setprio(1); _Pragma("unroll") for (int m = 0; m < 4; ++m) _Pragma("unroll") for (int n = 0; n < 2; ++n) _Pragma("unroll") for (int k = 0; k < 2; ++k) \
        acc[ai][bj][m][n] = __builtin_amdgcn_mfma_f32_16x16x32_bf16(Bt[n][k], At[m][k], acc[ai][bj][m][n], 0, 0, 0); __builtin_amdgcn_s_setprio(0); } while (0)
#define PG8_WAIT_V(n) asm volatile("s_waitcnt vmcnt(" #n ")" ::: "memory")
#define PG8_WAIT_L(n) asm volatile("s_waitcnt lgkmcnt(" #n ")" ::: "memory")
#define PG8_BAR __builtin_amdgcn_s_barrier()
#define PG8_SCHED __builtin_amdgcn_sched_barrier(0)
    Unit cur, nxt; int ui = 0;
    if (!S.next(0, cur)) return;
    f32x4 acc[2][2][4][2];
#pragma unroll
    for (int a = 0; a < 2; ++a)
#pragma unroll
        for (int b = 0; b < 2; ++b)
#pragma unroll
            for (int m = 0; m < 4; ++m)
#pragma unroll
                for (int n = 0; n < 2; ++n) acc[a][b][m][n] = (f32x4){0.f, 0.f, 0.f, 0.f};
    bf16x8 At[4][2], B0[2][2], B1[2][2];
    const char* cA = (const char*)g.A + (size_t)cur.pm * tstep; const char* cB = (const char*)g.Bt + (size_t)cur.pn * tstep;
    S.a_ready(cur);
    if constexpr (SP2) {
        PG8_STAGE(PG8_SB(0, 0), cB, voffB); PG8_STAGE(PG8_SB(0, 1), cB + hstep, voffB); PG8_STAGE(PG8_SA(0, 0), cA, voffA); PG8_STAGE(PG8_SA(0, 1), cA + hstep, voffA);
        if (wr == 1) PG8_BAR;
        PG8_WAIT_V(2); PG8_BAR;
        PG8_STAGE(PG8_SB(1, 0), cB + kstep, voffB); PG8_STAGE(PG8_SA(1, 0), cA + kstep, voffA); PG8_STAGE(PG8_SB(1, 1), cB + hstep + kstep, voffB);
        PG8_WAIT_V(6); PG8_BAR;
    } else {
        PG8_STAGE(PG8_SB(0, 0), cB, voffB); PG8_STAGE(PG8_SA(0, 0), cA, voffA); PG8_STAGE(PG8_SB(0, 1), cB + hstep, voffB); PG8_STAGE(PG8_SA(0, 1), cA + hstep, voffA);
        if (wr == 1) PG8_BAR;
        PG8_WAIT_V(4); PG8_BAR;
        PG8_STAGE(PG8_SB(1, 0), cB + kstep, voffB); PG8_STAGE(PG8_SA(1, 0), cA + kstep, voffA); PG8_STAGE(PG8_SB(1, 1), cB + hstep + kstep, voffB);
        PG8_WAIT_V(6); PG8_BAR;
    }
    for (;;) {
        const bool has_next = S.next(ui + 1, nxt);
        const char* nA = has_next ? (const char*)g.A + (size_t)nxt.pm * tstep : cA; const char* nB = has_next ? (const char*)g.Bt + (size_t)nxt.pn * tstep : cB;
        for (int t = 0; t < nt; t += 2) {
            const bool last = (t == nt - 2);
            const char* a1 = cA + (size_t)(t + 1) * kstep;
            const char* a2 = last ? nA : cA + (size_t)(t + 2) * kstep; const char* b2 = last ? nB : cB + (size_t)(t + 2) * kstep;
            const char* a3 = a2 + kstep; const char* b3 = b2 + kstep;
            if (last && has_next) S.a_ready(nxt);
            if constexpr (SP2) {
            PG8_LDB(B0, 0, 0); PG8_LDB(B1, 0, 1); PG8_SCHED; PG8_LDA(At, 0, 0); PG8_STAGE(PG8_SA(1, 1), a1 + hstep, voffA);
            PG8_WAIT_V(8); PG8_WAIT_L(0); PG8_BAR; PG8_MMA(0, 0, At, B0); PG8_MMA(0, 1, At, B1); PG8_BAR; PG8_SCHED;
            PG8_LDA(At, 0, 1); PG8_STAGE(PG8_SB(0, 0), b2, voffB); PG8_STAGE(PG8_SB(0, 1), b2 + hstep, voffB); PG8_STAGE(PG8_SA(0, 0), a2, voffA);
            PG8_WAIT_V(8); PG8_WAIT_L(0); PG8_BAR; PG8_MMA(1, 0, At, B0); PG8_MMA(1, 1, At, B1); PG8_BAR; PG8_SCHED;
            PG8_LDB(B0, 1, 0); PG8_LDB(B1, 1, 1); PG8_SCHED; PG8_LDA(At, 1, 0); PG8_STAGE(PG8_SA(0, 1), a2 + hstep, voffA);
            PG8_WAIT_V(8); PG8_WAIT_L(0); PG8_BAR; PG8_MMA(0, 0, At, B0); PG8_MMA(0, 1, At, B1); PG8_BAR; PG8_SCHED;
            PG8_LDA(At, 1, 1); PG8_STAGE(PG8_SB(1, 0), b3, voffB); PG8_STAGE(PG8_SB(1, 1), b3 + hstep, voffB); PG8_STAGE(PG8_SA(1, 0), a3, voffA);
            PG8_WAIT_V(8); PG8_WAIT_L(0); PG8_BAR; PG8_MMA(1, 0, At, B0); PG8_MMA(1, 1, At, B1); PG8_BAR; PG8_SCHED;
            } else {
            PG8_LDB(B0, 0, 0); PG8_SCHED; PG8_LDA(At, 0, 0); PG8_STAGE(PG8_SA(1, 1), a1 + hstep, voffA);
            PG8_WAIT_L(8); PG8_BAR; PG8_WAIT_L(0); PG8_MMA(0, 0, At, B0); PG8_BAR; PG8_SCHED;
            PG8_LDB(B1, 0, 1); PG8_STAGE(PG8_SB(0, 0), b2, voffB);
            PG8_BAR; PG8_WAIT_L(0); PG8_MMA(0, 1, At, B1); PG8_BAR;
            PG8_LDA(At, 0, 1); PG8_STAGE(PG8_SA(0, 0), a2, voffA);
            PG8_BAR; PG8_WAIT_L(0); PG8_MMA(1, 0, At, B0); PG8_BAR; PG8_SCHED;
            PG8_STAGE(PG8_SB(0, 1), b2 + hstep, voffB);
            PG8_WAIT_V(6); PG8_BAR; PG8_MMA(1, 1, At, B1); PG8_BAR;
            PG8_LDB(B0, 1, 0); PG8_SCHED; PG8_LDA(At, 1, 0); PG8_STAGE(PG8_SA(0, 1), a2 + hstep, voffA);
            PG8_WAIT_L(8); PG8_BAR; PG8_WAIT_L(0); PG8_MMA(0, 0, At, B0); PG8_BAR; PG8_SCHED;
            PG8_LDB(B1, 1, 1); PG8_STAGE(PG8_SB(1, 0), b3, voffB);
            PG8_BAR; PG8_WAIT_L(0); PG8_MMA(0, 1, At, B1); PG8_BAR;
            PG8_LDA(At, 1, 1); PG8_STAGE(PG8_SA(1, 0), a3, voffA);
            PG8_BAR; PG8_WAIT_L(0); PG8_MMA(1, 0, At, B0); PG8_BAR; PG8_SCHED;
            PG8_STAGE(PG8_SB(1, 1), b3 + hstep, voffB);
            PG8_WAIT_V(6); PG8_BAR; PG8_MMA(1, 1, At, B1); PG8_BAR;
            }
        }
        if constexpr (ALIGN_EPI) { if (wr == 0) PG8_BAR; }
        if constexpr (!Epi::AFTER_DRAIN) { E(acc, cur, wr, wc, fr, fq); S.done(cur); }
        if (!has_next) break;
#pragma unroll
        for (int a = 0; a < 2; ++a)
#pragma unroll
            for (int b = 0; b < 2; ++b)
#pragma unroll
                for (int m = 0; m < 4; ++m)
#pragma unroll
                    for (int n = 0; n < 2; ++n) acc[a][b][m][n] = (f32x4){0.f, 0.f, 0.f, 0.f};
        cur = nxt; cA = nA; cB = nB; ++ui;
        if constexpr (ALIGN_EPI) { if (wr == 1) PG8_BAR; }
    }
    PG8_WAIT_V(0);
    if constexpr (!ALIGN_EPI) { if (wr == 0) PG8_BAR; }
    PG8_BAR;
    if constexpr (Epi::AFTER_DRAIN) { E.fused(acc, cur, wr, wc, fr, fq, lds, wid, lane); S.done(cur); }
#undef PG8_SA
#undef PG8_SB
#undef PG8_STAGE
#undef PG8_LDA
#undef PG8_LDB
#undef PG8_MMA
#undef PG8_WAIT_V
#undef PG8_WAIT_L
#undef PG8_BAR
#undef PG8_SCHED
}
}
namespace mx {
typedef unsigned char uchar;
typedef unsigned short bf16_t;
typedef short bf16x8 __attribute__((ext_vector_type(8)));
typedef float f32x4 __attribute__((ext_vector_type(4)));
typedef unsigned u32x4 __attribute__((ext_vector_type(4)));
typedef unsigned u32x2 __attribute__((ext_vector_type(2)));
#define MXL __attribute__((address_space(3)))
__device__ __forceinline__ unsigned f2bf(float f) { unsigned u = __builtin_bit_cast(unsigned, f); return (u + 0x7fffu + ((u >> 16) & 1u)) >> 16; }
__device__ __forceinline__ unsigned pk2(float lo, float hi) { return f2bf(lo) | (f2bf(hi) << 16); }
__device__ __forceinline__ float bf2f(unsigned h) { return __builtin_bit_cast(float, h << 16); }
__device__ __forceinline__ bf16x8 ldfrag(const MXL uchar* p) { return *(const MXL bf16x8*)p; }
__device__ __forceinline__ f32x4 mma(bf16x8 a, bf16x8 b, f32x4 c) { return __builtin_amdgcn_mfma_f32_16x16x32_bf16(a, b, c, 0, 0, 0); }

struct HgrnP { const bf16_t* Q; const float* LF; const bf16_t* V; const bf16_t* G; bf16_t* ST; float* DEC; bf16_t* O; const float* norm_w; };

__device__ __forceinline__ void vt_issue(const bf16_t* V, size_t rowbase, int col0, int tid, u32x4& v0, u32x4& v1) {
    const bf16_t* vp = V + (rowbase + (tid & 63)) * 1024 + col0 + (tid >> 6) * 16; v0 = *(const u32x4*)vp; v1 = *(const u32x4*)(vp + 8);
}
__device__ __forceinline__ void vt_write(MXL bf16_t* VT, int tid, const u32x4& v0, const u32x4& v1) {
    const int s = tid & 63, e0 = (tid >> 6) * 16;
#pragma unroll
    for (int j = 0; j < 4; ++j) { VT[(e0 + 2 * j) * 72 + s] = (bf16_t)(v0[j] & 0xffffu); VT[(e0 + 2 * j + 1) * 72 + s] = (bf16_t)(v0[j] >> 16);
                                  VT[(e0 + 8 + 2 * j) * 72 + s] = (bf16_t)(v1[j] & 0xffffu); VT[(e0 + 8 + 2 * j + 1) * 72 + s] = (bf16_t)(v1[j] >> 16); }
}

__device__ __forceinline__ void hgrn_p2a(MXL uchar* lds, const HgrnP& p) {
    const int tid = threadIdx.x, lane = tid & 63, wid = tid >> 6, d = tid & 127, qt = tid >> 7, fr = lane & 15, fq = lane >> 4;
    MXL uchar* KD = lds; MXL uchar* VTb = lds + 18432; MXL float* QS = (MXL float*)(lds + 36864);
    for (int unit = blockIdx.x; unit < 2048; unit += gridDim.x) {
        const int c = unit >> 3, h = unit & 7; const size_t rowbase = (size_t)c * 64;
        float b[16], k[16];
        { const float* lfp = p.LF + (rowbase + qt * 16) * 1024 + h * 128 + d;
#pragma unroll
          for (int i = 0; i < 16; ++i) b[i] = lfp[(size_t)i * 1024]; }
        u32x4 v0, v1; vt_issue(p.V, rowbase, h * 128, tid, v0, v1);
#pragma unroll
        for (int i = 0; i < 16; ++i) k[i] = 1.f - __expf(b[i]);
#pragma unroll
        for (int i = 1; i < 16; ++i) b[i] += b[i - 1];
        QS[qt * 128 + d] = b[15];
        vt_write((MXL bf16_t*)VTb, tid, v0, v1);
        __syncthreads();
        float off = 0.f, tot = 0.f;
#pragma unroll
        for (int q = 0; q < 4; ++q) { const float x = QS[q * 128 + d]; off += q < qt ? x : 0.f; tot += x; }
        { u32x4 o0, o1; float kd[16];
#pragma unroll
          for (int i = 0; i < 16; ++i) kd[i] = k[i] * __expf(tot - (b[i] + off));
          o0.x = pk2(kd[0], kd[1]); o0.y = pk2(kd[2], kd[3]); o0.z = pk2(kd[4], kd[5]); o0.w = pk2(kd[6], kd[7]);
          o1.x = pk2(kd[8], kd[9]); o1.y = pk2(kd[10], kd[11]); o1.z = pk2(kd[12], kd[13]); o1.w = pk2(kd[14], kd[15]);
          MXL u32x4* dst = (MXL u32x4*)(KD + d * 144 + qt * 32); dst[0] = o0; dst[1] = o1; }
        if (qt == 0) p.DEC[(size_t)unit * 128 + d] = __expf(tot);
        __syncthreads();
        {
            const bf16x8 bv0 = ldfrag(VTb + (wid * 16 + fr) * 144 + fq * 16), bv1 = ldfrag(VTb + (wid * 16 + fr) * 144 + 64 + fq * 16);
            bf16_t* st = p.ST + (size_t)unit * 16384 + (wid * 16 + fr) * 128 + 4 * fq;
#pragma unroll
            for (int dt = 0; dt < 8; ++dt) {
                f32x4 acc = {0.f, 0.f, 0.f, 0.f};
                acc = mma(ldfrag(KD + (dt * 16 + fr) * 144 + fq * 16), bv0, acc);
                acc = mma(ldfrag(KD + (dt * 16 + fr) * 144 + 64 + fq * 16), bv1, acc);
                u32x2 w; w.x = pk2(acc[0], acc[1]); w.y = pk2(acc[2], acc[3]);
                *(u32x2*)(st + dt * 16) = w;
            }
        }
        __syncthreads();
    }
}

__device__ __forceinline__ void hgrn_p2b(const HgrnP& p) {
    for (int pid = blockIdx.x * 512 + threadIdx.x; pid < 65536; pid += gridDim.x * 512) {
        const int h = pid >> 13, idx2 = (pid & 8191) * 2, d = idx2 & 127;
        float S0 = 0.f, S1 = 0.f;
        for (int c0 = 0; c0 < 256; c0 += 16) {
            unsigned u[16]; float2 a[16];
#pragma unroll
            for (int i = 0; i < 16; ++i) { const size_t unit = (size_t)(c0 + i) * 8 + h; u[i] = *(const unsigned*)(p.ST + unit * 16384 + idx2); a[i] = *(const float2*)(p.DEC + unit * 128 + d); }
#pragma unroll
            for (int i = 0; i < 16; ++i) { const size_t unit = (size_t)(c0 + i) * 8 + h;
                *(unsigned*)(p.ST + unit * 16384 + idx2) = pk2(S0, S1);
                S0 = a[i].x * S0 + bf2f(u[i] & 0xffffu); S1 = a[i].y * S1 + bf2f(u[i] >> 16); }
        }
    }
}

__device__ __forceinline__ void hgrn_p2c(MXL uchar* lds, const HgrnP& p) {
    const int tid = threadIdx.x, lane = tid & 63, wid = tid >> 6, d = tid & 127, qt = tid >> 7, fr = lane & 15, fq = lane >> 4;
    MXL uchar* QT = lds; MXL uchar* KT = lds + 17408; MXL uchar* QE = lds + 34816; MXL uchar* VTb = lds + 52224; MXL uchar* STI = lds + 70656; MXL uchar* ATT = lds + 105472;
    MXL float* QS = (MXL float*)(lds + 114688); MXL float* BMID = (MXL float*)(lds + 116736); MXL float* RED = (MXL float*)(lds + 117248);
    for (int unit = blockIdx.x; unit < 2048; unit += gridDim.x) {
        const int c = unit >> 3, h = unit & 7; const size_t rowbase = (size_t)c * 64;
        float b[16], k[16]; unsigned short qraw[16];
        { const float* lfp = p.LF + (rowbase + qt * 16) * 1024 + h * 128 + d; const bf16_t* qp = p.Q + (rowbase + qt * 16) * 1024 + h * 128 + d;
#pragma unroll
          for (int i = 0; i < 16; ++i) { b[i] = lfp[(size_t)i * 1024]; qraw[i] = qp[(size_t)i * 1024]; } }
        u32x4 v0, v1; vt_issue(p.V, rowbase, h * 128, tid, v0, v1);
        u32x4 sv[4];
        { const bf16_t* sp = p.ST + (size_t)unit * 16384;
#pragma unroll
          for (int i = 0; i < 4; ++i) sv[i] = *(const u32x4*)(sp + (size_t)(tid + 512 * i) * 8); }
#pragma unroll
        for (int i = 0; i < 16; ++i) k[i] = 1.f - __expf(b[i]);
#pragma unroll
        for (int i = 1; i < 16; ++i) b[i] += b[i - 1];
        QS[qt * 128 + d] = b[15];
        vt_write((MXL bf16_t*)VTb, tid, v0, v1);
#pragma unroll
        for (int i = 0; i < 4; ++i) { const int id = tid + 512 * i, e = id >> 4, ch = id & 15; *(MXL u32x4*)(STI + e * 272 + ch * 16) = sv[i]; }
        __syncthreads();
        float off = 0.f;
#pragma unroll
        for (int q = 0; q < 4; ++q) { const float x = QS[q * 128 + d]; off += q < qt ? x : 0.f; }
#pragma unroll
        for (int i = 0; i < 16; ++i) b[i] += off;
        if (qt == 1) BMID[d] = b[15];
        __syncthreads();
        { const float bm = BMID[d];
#pragma unroll
          for (int i = 0; i < 16; ++i) { const int t = qt * 16 + i; const float e1 = __expf(b[i] - bm), qf = bf2f(qraw[i]);
              ((MXL bf16_t*)QT)[t * 136 + d] = (bf16_t)f2bf(qf * e1); ((MXL bf16_t*)KT)[t * 136 + d] = (bf16_t)f2bf(k[i] / e1); ((MXL bf16_t*)QE)[t * 136 + d] = (bf16_t)f2bf(qf * __expf(b[i])); } }
        __syncthreads();
        {
            const int tt = wid >> 1;
            bf16x8 qf[4];
#pragma unroll
            for (int ks = 0; ks < 4; ++ks) qf[ks] = ldfrag(QT + (tt * 16 + fr) * 272 + ks * 64 + fq * 16);
#pragma unroll
            for (int j = 0; j < 2; ++j) { const int sti = (wid & 1) * 2 + j; f32x4 acc = {0.f, 0.f, 0.f, 0.f};
                if (sti <= tt) {
#pragma unroll
                    for (int ks = 0; ks < 4; ++ks) acc = mma(ldfrag(KT + (sti * 16 + fr) * 272 + ks * 64 + fq * 16), qf[ks], acc);
                }
                const int t = tt * 16 + fr, s0 = sti * 16 + 4 * fq;
                float a0 = (s0 + 0 <= t) ? acc[0] : 0.f, a1 = (s0 + 1 <= t) ? acc[1] : 0.f, a2 = (s0 + 2 <= t) ? acc[2] : 0.f, a3 = (s0 + 3 <= t) ? acc[3] : 0.f;
                if (sti > tt) { a0 = 0.f; a1 = 0.f; a2 = 0.f; a3 = 0.f; }
                u32x2 w; w.x = pk2(a0, a1); w.y = pk2(a2, a3);
                *(MXL u32x2*)(ATT + t * 144 + s0 * 2) = w; }
        }
        __syncthreads();
        {
            const int tt = wid & 3, eh = wid >> 2, t = tt * 16 + fr;
            bf16x8 af[2], qe[4];
#pragma unroll
            for (int ks = 0; ks < 2; ++ks) af[ks] = ldfrag(ATT + t * 144 + ks * 64 + fq * 16);
#pragma unroll
            for (int ks = 0; ks < 4; ++ks) qe[ks] = ldfrag(QE + t * 272 + ks * 64 + fq * 16);
            f32x4 acc[4]; float ss = 0.f;
#pragma unroll
            for (int et = 0; et < 4; ++et) { const int er = eh * 64 + et * 16 + fr; f32x4 a = {0.f, 0.f, 0.f, 0.f};
#pragma unroll
                for (int ks = 0; ks < 2; ++ks) a = mma(ldfrag(VTb + er * 144 + ks * 64 + fq * 16), af[ks], a);
#pragma unroll
                for (int ks = 0; ks < 4; ++ks) a = mma(ldfrag(STI + er * 272 + ks * 64 + fq * 16), qe[ks], a);
                acc[et] = a; ss += (a[0] * a[0] + a[1] * a[1]) + (a[2] * a[2] + a[3] * a[3]); }
            ss += __shfl_xor(ss, 16); ss += __shfl_xor(ss, 32);
            if (lane < 16) RED[eh * 64 + t] = ss;
            __syncthreads();
            const float r = rsqrtf((RED[t] + RED[64 + t]) * (1.f / 128.f) + HN_EPS);
#pragma unroll
            for (int et = 0; et < 4; ++et) { const int e0 = eh * 64 + et * 16 + 4 * fq; const size_t go = (rowbase + t) * 1024 + h * 128 + e0;
                const u32x2 g = *(const u32x2*)(p.G + go); const f32x4 nw = *(const f32x4*)(p.norm_w + e0);
                u32x2 w; w.x = pk2(acc[et][0] * r * nw[0] * bf2f(g.x & 0xffffu), acc[et][1] * r * nw[1] * bf2f(g.x >> 16));
                w.y = pk2(acc[et][2] * r * nw[2] * bf2f(g.y & 0xffffu), acc[et][3] * r * nw[3] * bf2f(g.y >> 16));
                *(u32x2*)(p.O + go) = w; }
        }
        __syncthreads();
    }
}
}
namespace mx {
struct MlstmP { const bf16_t* QK; const bf16_t* V; const bf16_t* OG; const float* GATES; bf16_t* CT; float* NL; float* NP; float* BL; float* ML; float* MP; bf16_t* O; const float* conv_w; const float* norm_w; };

__device__ __forceinline__ float wave_incl_sum(float v, int lane) {
#pragma unroll
    for (int o = 1; o < 64; o <<= 1) { const float t = __shfl_up(v, o); if (lane >= o) v += t; }
    return v;
}
__device__ __forceinline__ float wave_incl_max(float v, int lane) {
#pragma unroll
    for (int o = 1; o < 64; o <<= 1) { const float t = __shfl_up(v, o); if (lane >= o) v = fmaxf(v, t); }
    return v;
}
__device__ __forceinline__ float wave_max(float v) {
#pragma unroll
    for (int o = 1; o < 64; o <<= 1) v = fmaxf(v, __shfl_xor(v, o));
    return v;
}
__device__ __forceinline__ float wave_sum(float v) {
#pragma unroll
    for (int o = 1; o < 64; o <<= 1) v += __shfl_xor(v, o);
    return v;
}
__device__ __forceinline__ void mlstm_gates(MXL uchar* lds, const float* x, const float* w_in  , const float* gate_b, float* GATES) {
    const int tid = threadIdx.x, lane = tid & 63, wid = tid >> 6;
    MXL float* wT = (MXL float*)lds;
    for (int i = 0; i < 8; ++i) { const int id = tid + 512 * i, k = id >> 2, o4 = id & 3; const float4 w = *(const float4*)(w_in + (size_t)k * 3088 + 3072 + 4 * o4);
        wT[(4 * o4 + 0) * 1024 + k] = w.x; wT[(4 * o4 + 1) * 1024 + k] = w.y; wT[(4 * o4 + 2) * 1024 + k] = w.z; wT[(4 * o4 + 3) * 1024 + k] = w.w; }
    __syncthreads();
    const float gb = lane < 16 ? gate_b[lane] : 0.f;
    for (int row = blockIdx.x * 8 + wid; row < L; row += gridDim.x * 8) {
        float4 xv[4];
#pragma unroll
        for (int i = 0; i < 4; ++i) xv[i] = *(const float4*)(x + (size_t)row * 1024 + 256 * i + 4 * lane);
        float res = 0.f;
#pragma unroll 1
        for (int o = 0; o < 16; ++o) { float a = 0.f;
#pragma unroll
            for (int i = 0; i < 4; ++i) { const f32x4 w = *(const MXL f32x4*)(wT + o * 1024 + 256 * i + 4 * lane); a += xv[i].x * w[0] + xv[i].y * w[1] + xv[i].z * w[2] + xv[i].w * w[3]; }
            a = wave_sum(a); if (lane == o) res = a; }
        if (lane < 16) { float g = res + gb; if (lane >= 8) g = fminf(g, 0.f) - log1pf(__expf(-fabsf(g))); GATES[(size_t)row * 16 + lane] = g; }
    }
    __syncthreads();
}

__device__ __forceinline__ void conv8(const bf16_t* QK, size_t t0, int ch, const float* cw  , float (&out)[8]) {
    float pre[11];
#pragma unroll
    for (int i = 0; i < 11; ++i) { const long t = (long)t0 - 3 + i; pre[i] = t >= 0 ? bf2f(QK[(size_t)t * 1024 + ch]) : 0.f; }
    const float w0 = cw[ch], w1 = cw[1024 + ch], w2 = cw[2048 + ch], w3 = cw[3072 + ch];
#pragma unroll
    for (int i = 0; i < 8; ++i) { const float v = w0 * pre[i] + w1 * pre[i + 1] + w2 * pre[i + 2] + w3 * pre[i + 3]; out[i] = v / (1.f + __expf(-v)); }
}

__device__ __forceinline__ void mlstm_p2a(MXL uchar* lds, const MlstmP& p) {
    const int tid = threadIdx.x, lane = tid & 63, wid = tid >> 6, d = tid & 63, sq = tid >> 6, fr = lane & 15, fq = lane >> 4;
    MXL uchar* KWT = lds; MXL uchar* VTb = lds + 9216; MXL float* W = (MXL float*)(lds + 27648); MXL float* NRED = (MXL float*)(lds + 27904);
    for (int unit = blockIdx.x; unit < 2048; unit += gridDim.x) {
        const int c = unit >> 3, h = unit & 7; const size_t rowbase = (size_t)c * 64;
        if (wid == 0) {
            const float li = p.GATES[(rowbase + lane) * 16 + h], lf = p.GATES[(rowbase + lane) * 16 + 8 + h];
            const float b = wave_incl_sum(lf, lane), blast = __shfl(b, 63);
            const float lw = blast - b + li, mloc = wave_max(lw);
            W[lane] = __expf(lw - mloc);
            if (lane == 0) { p.BL[unit] = blast; p.ML[unit] = mloc; }
        }
        float k[8]; conv8(p.QK, rowbase + sq * 8, 512 + h * 64 + d, p.conv_w, k);
        u32x4 v0, v1; vt_issue(p.V, rowbase, h * 128, tid, v0, v1);
        __syncthreads();
        { float kw[8], ns = 0.f;
#pragma unroll
          for (int i = 0; i < 8; ++i) { kw[i] = k[i] * 0.125f * W[sq * 8 + i]; ns += kw[i]; }
          u32x4 o; o.x = pk2(kw[0], kw[1]); o.y = pk2(kw[2], kw[3]); o.z = pk2(kw[4], kw[5]); o.w = pk2(kw[6], kw[7]);
          *(MXL u32x4*)(KWT + d * 144 + sq * 16) = o; NRED[sq * 64 + d] = ns; }
        vt_write((MXL bf16_t*)VTb, tid, v0, v1);
        __syncthreads();
        {
            const bf16x8 bv0 = ldfrag(VTb + (wid * 16 + fr) * 144 + fq * 16), bv1 = ldfrag(VTb + (wid * 16 + fr) * 144 + 64 + fq * 16);
            bf16_t* ct = p.CT + (size_t)unit * 8192 + (wid * 16 + fr) * 64 + 4 * fq;
#pragma unroll
            for (int dt = 0; dt < 4; ++dt) { f32x4 acc = {0.f, 0.f, 0.f, 0.f};
                acc = mma(ldfrag(KWT + (dt * 16 + fr) * 144 + fq * 16), bv0, acc);
                acc = mma(ldfrag(KWT + (dt * 16 + fr) * 144 + 64 + fq * 16), bv1, acc);
                u32x2 w; w.x = pk2(acc[0], acc[1]); w.y = pk2(acc[2], acc[3]); *(u32x2*)(ct + dt * 16) = w; }
        }
        if (tid < 64) { float s = 0.f;
#pragma unroll
            for (int q = 0; q < 8; ++q) s += NRED[q * 64 + tid];
            p.NL[(size_t)unit * 64 + tid] = s; }
        __syncthreads();
    }
}

__device__ __forceinline__ void mlstm_p2b(const MlstmP& p) {
    for (int pid = blockIdx.x * 512 + threadIdx.x; pid < 33280; pid += gridDim.x * 512) {
        const bool isn = pid >= 32768;
        const int h = isn ? (pid - 32768) >> 6 : pid >> 12, idx = isn ? (pid - 32768) & 63 : (pid & 4095) * 2;
        float m = 0.f, C0 = 0.f, C1 = 0.f;
        for (int c0 = 0; c0 < 256; c0 += 16) {
            unsigned u[16]; float bl[16], ml[16];
#pragma unroll
            for (int i = 0; i < 16; ++i) { const size_t unit = (size_t)(c0 + i) * 8 + h; bl[i] = p.BL[unit]; ml[i] = p.ML[unit];
                u[i] = isn ? __builtin_bit_cast(unsigned, p.NL[unit * 64 + idx]) : *(const unsigned*)(p.CT + unit * 8192 + idx); }
#pragma unroll
            for (int i = 0; i < 16; ++i) { const size_t unit = (size_t)(c0 + i) * 8 + h;
                const float mn = fmaxf(bl[i] + m, ml[i]), al = __expf(bl[i] + m - mn), be = __expf(ml[i] - mn);
                if (isn) { p.NP[unit * 64 + idx] = C0; if (idx == 0) p.MP[unit] = m; C0 = al * C0 + be * __builtin_bit_cast(float, u[i]); }
                else { *(unsigned*)(p.CT + unit * 8192 + idx) = pk2(C0, C1); C0 = al * C0 + be * bf2f(u[i] & 0xffffu); C1 = al * C1 + be * bf2f(u[i] >> 16); }
                m = mn; }
        }
    }
}

__device__ __forceinline__ void mlstm_p2c(MXL uchar* lds, const MlstmP& p) {
    const int tid = threadIdx.x, lane = tid & 63, wid = tid >> 6, d = tid & 63, sq = tid >> 6, fr = lane & 15, fq = lane >> 4;
    MXL uchar* QM = lds; MXL uchar* KM = lds + 9216; MXL uchar* QI = lds + 18432; MXL uchar* VTb = lds + 27648; MXL uchar* CTI = lds + 46080; MXL uchar* ATT = lds + 64512;
    MXL float* GS = (MXL float*)(lds + 73728); MXL float* MT = (MXL float*)(lds + 73984); MXL float* WI = (MXL float*)(lds + 74240); MXL float* EM = (MXL float*)(lds + 74496);
    MXL float* DENP = (MXL float*)(lds + 74752); MXL float* QN = (MXL float*)(lds + 75264); MXL float* NPL = (MXL float*)(lds + 75520); MXL float* RED = (MXL float*)(lds + 75776);
    for (int unit = blockIdx.x; unit < 2048; unit += gridDim.x) {
        const int c = unit >> 3, h = unit & 7; const size_t rowbase = (size_t)c * 64;
        if (wid == 0) {
            const float li = p.GATES[(rowbase + lane) * 16 + h], lf = p.GATES[(rowbase + lane) * 16 + 8 + h];
            const float b = wave_incl_sum(lf, lane), g = li - b, pm = wave_incl_max(g, lane), mprev = p.MP[unit], M = fmaxf(pm, mprev);
            GS[lane] = g; MT[lane] = M; WI[lane] = __expf(mprev - M); EM[lane] = __expf(-(b + M));
        }
        if (wid == 1) NPL[lane] = p.NP[(size_t)unit * 64 + lane];
        float q[8], k[8]; conv8(p.QK, rowbase + sq * 8, h * 64 + d, p.conv_w, q); conv8(p.QK, rowbase + sq * 8, 512 + h * 64 + d, p.conv_w, k);
        u32x4 v0, v1; vt_issue(p.V, rowbase, h * 128, tid, v0, v1);
        u32x4 cv[2];
        { const bf16_t* cp = p.CT + (size_t)unit * 8192;
#pragma unroll
          for (int i = 0; i < 2; ++i) cv[i] = *(const u32x4*)(cp + (size_t)(tid + 512 * i) * 8); }
        __syncthreads();
        { const float nd = NPL[d];
#pragma unroll
          for (int i = 0; i < 8; ++i) { const int t = sq * 8 + i;
              ((MXL bf16_t*)QM)[t * 72 + d] = (bf16_t)f2bf(q[i]); ((MXL bf16_t*)KM)[t * 72 + d] = (bf16_t)f2bf(k[i] * 0.125f); ((MXL bf16_t*)QI)[t * 72 + d] = (bf16_t)f2bf(q[i] * WI[t]);
              const float qn = wave_sum(q[i] * nd); if (lane == 0) QN[t] = qn; } }
        vt_write((MXL bf16_t*)VTb, tid, v0, v1);
#pragma unroll
        for (int i = 0; i < 2; ++i) { const int id = tid + 512 * i, e = id >> 3, ch = id & 7; *(MXL u32x4*)(CTI + e * 144 + ch * 16) = cv[i]; }
        __syncthreads();
        {
            const int tt = wid >> 1, t = tt * 16 + fr; const float Mt = MT[t];
            const bf16x8 qf0 = ldfrag(QM + t * 144 + fq * 16), qf1 = ldfrag(QM + t * 144 + 64 + fq * 16);
            float dsum = 0.f;
#pragma unroll
            for (int j = 0; j < 2; ++j) { const int sti = (wid & 1) * 2 + j, s0 = sti * 16 + 4 * fq; f32x4 acc = {0.f, 0.f, 0.f, 0.f};
                if (sti <= tt) { acc = mma(ldfrag(KM + (sti * 16 + fr) * 144 + fq * 16), qf0, acc); acc = mma(ldfrag(KM + (sti * 16 + fr) * 144 + 64 + fq * 16), qf1, acc); }
                float a[4];
#pragma unroll
                for (int r = 0; r < 4; ++r) { const int s = s0 + r; a[r] = (s <= t) ? acc[r] * __expf(GS[s] - Mt) : 0.f; dsum += a[r]; }
                u32x2 w; w.x = pk2(a[0], a[1]); w.y = pk2(a[2], a[3]); *(MXL u32x2*)(ATT + t * 144 + s0 * 2) = w; }
            dsum += __shfl_xor(dsum, 16); dsum += __shfl_xor(dsum, 32);
            if (lane < 16) DENP[(wid & 1) * 64 + t] = dsum;
        }
        __syncthreads();
        {
            const int tt = wid & 3, eh = wid >> 2, t = tt * 16 + fr;
            const bf16x8 af0 = ldfrag(ATT + t * 144 + fq * 16), af1 = ldfrag(ATT + t * 144 + 64 + fq * 16), qi0 = ldfrag(QI + t * 144 + fq * 16), qi1 = ldfrag(QI + t * 144 + 64 + fq * 16);
            const float den = DENP[t] + DENP[64 + t] + WI[t] * QN[t], inv = 1.f / fmaxf(fabsf(den), EM[t]);
            f32x4 acc[4]; float ss = 0.f;
#pragma unroll
            for (int et = 0; et < 4; ++et) { const int er = eh * 64 + et * 16 + fr; f32x4 a = {0.f, 0.f, 0.f, 0.f};
                a = mma(ldfrag(VTb + er * 144 + fq * 16), af0, a); a = mma(ldfrag(VTb + er * 144 + 64 + fq * 16), af1, a);
                a = mma(ldfrag(CTI + er * 144 + fq * 16), qi0, a); a = mma(ldfrag(CTI + er * 144 + 64 + fq * 16), qi1, a);
                a = a * inv; acc[et] = a; ss += (a[0] * a[0] + a[1] * a[1]) + (a[2] * a[2] + a[3] * a[3]); }
            ss += __shfl_xor(ss, 16); ss += __shfl_xor(ss, 32);
            if (lane < 16) RED[eh * 64 + t] = ss;
            __syncthreads();
            const float r = rsqrtf((RED[t] + RED[64 + t]) * (1.f / 128.f) + HN_EPS);
#pragma unroll
            for (int et = 0; et < 4; ++et) { const int e0 = eh * 64 + et * 16 + 4 * fq; const size_t go = (rowbase + t) * 1024 + h * 128 + e0;
                const u32x2 g = *(const u32x2*)(p.OG + go); const f32x4 nw = *(const f32x4*)(p.norm_w + h * 128 + e0);
                u32x2 w; w.x = pk2(acc[et][0] * r * nw[0] * bf2f(g.x & 0xffffu), acc[et][1] * r * nw[1] * bf2f(g.x >> 16));
                w.y = pk2(acc[et][2] * r * nw[2] * bf2f(g.y & 0xffffu), acc[et][3] * r * nw[3] * bf2f(g.y >> 16));
                *(u32x2*)(p.O + go) = w; }
        }
        __syncthreads();
    }
}
}
namespace mx {
typedef float f32x16 __attribute__((ext_vector_type(16)));
struct S5P { const bf16_t* U5; bf16_t* Y; const float* AB; const float* A256; const bf16_t* BB; const bf16_t* CC; float* E; const float* dsk; };

__device__ __forceinline__ void s5_tables(const float* a_re, const float* a_im, const float* log_dt, const float* b_re, const float* b_im, const float* c_re, const float* c_im,
                                          float* AB, float* A256, bf16_t* BB, bf16_t* CC) {
    for (int id = blockIdx.x * 512 + threadIdx.x; id < 4096; id += gridDim.x * 512) {
        const int g = id >> 6, p = id & 63;
        const float dt = expf(log_dt[g]), ar = a_re[id], ai = a_im[id], mag = expf(ar * dt);
        const float abr = mag * cosf(ai * dt), abi = mag * sinf(ai * dt), nr = abr - 1.f, ni = abi, den = ar * ar + ai * ai;
        const float cr = (nr * ar + ni * ai) / den, ci = (ni * ar - nr * ai) / den;
        AB[id * 2] = abr; AB[id * 2 + 1] = abi;
        float xr = abr, xi = abi;
        for (int i = 0; i < 8; ++i) { const float tr = xr * xr - xi * xi, ti = 2.f * xr * xi; xr = tr; xi = ti; }
        A256[id * 2] = xr; A256[id * 2 + 1] = xi;
        for (int c = 0; c < 16; ++c) { const float br = b_re[id * 16 + c], bi = b_im[id * 16 + c];
            BB[(g * 128 + p) * 16 + c] = (bf16_t)f2bf(cr * br - ci * bi); BB[(g * 128 + 64 + p) * 16 + c] = (bf16_t)f2bf(cr * bi + ci * br);
            CC[(g * 16 + c) * 128 + p] = (bf16_t)f2bf(c_re[(g * 16 + c) * 64 + p]); CC[(g * 16 + c) * 128 + 64 + p] = (bf16_t)f2bf(-c_im[(g * 16 + c) * 64 + p]); }
    }
}

#define S5_SCAN16(ACC0, ACC1, ACC2, ACC3, BODY) _Pragma("unroll") for (int reg = 0; reg < 16; ++reg) { \
        const float n0r = a0r * s0r - a0i * s0i + ACC0[reg], n0i = a0r * s0i + a0i * s0r + ACC2[reg]; s0r = n0r; s0i = n0i; \
        const float n1r = a1r * s1r - a1i * s1i + ACC1[reg], n1i = a1r * s1i + a1i * s1r + ACC3[reg]; s1r = n1r; s1i = n1i; BODY }

__device__ __forceinline__ void s5_p1(const S5P& p) {
    const int tid = threadIdx.x, lane = tid & 63, wid = tid >> 6, hi = lane >> 5, l31 = lane & 31;
    const int hi_r = (l31 >> 2) & 1, reg_r = (l31 & 3) + 4 * (l31 >> 3);
    const f32x16 zero = {0.f, 0.f, 0.f, 0.f, 0.f, 0.f, 0.f, 0.f, 0.f, 0.f, 0.f, 0.f, 0.f, 0.f, 0.f, 0.f};
    for (int unit = blockIdx.x; unit < 256; unit += gridDim.x) {
        const int g = (unit & 7) * 8 + wid, sp = unit >> 3;
        bf16x8 bfr[4];
#pragma unroll
        for (int jt = 0; jt < 4; ++jt) bfr[jt] = *(const bf16x8*)(p.BB + ((size_t)(g * 128 + jt * 32 + l31)) * 16 + 8 * hi);
        const float a0r = p.AB[(g * 64 + l31) * 2], a0i = p.AB[(g * 64 + l31) * 2 + 1], a1r = p.AB[(g * 64 + 32 + l31) * 2], a1i = p.AB[(g * 64 + 32 + l31) * 2 + 1];
        const bf16_t* ub = p.U5 + ((size_t)(2 * sp + hi_r) * 256 + reg_r) * 1024 + 16 * g + 8 * hi;
        float s0r = 0.f, s0i = 0.f, s1r = 0.f, s1i = 0.f;
        bf16x8 af = *(const bf16x8*)ub;
        for (int it = 0; it < 16; ++it) {
            const bf16x8 nx = *(const bf16x8*)(ub + (size_t)(it < 15 ? it + 1 : it) * 16384);
            const f32x16 c0 = __builtin_amdgcn_mfma_f32_32x32x16_bf16(af, bfr[0], zero, 0, 0, 0), c1 = __builtin_amdgcn_mfma_f32_32x32x16_bf16(af, bfr[1], zero, 0, 0, 0);
            const f32x16 c2 = __builtin_amdgcn_mfma_f32_32x32x16_bf16(af, bfr[2], zero, 0, 0, 0), c3 = __builtin_amdgcn_mfma_f32_32x32x16_bf16(af, bfr[3], zero, 0, 0, 0);
            S5_SCAN16(c0, c1, c2, c3, )
            af = nx;
        }
        float* e = p.E + ((size_t)((2 * sp + hi) * 64 + g) * 64) * 2;
        *(float2*)(e + l31 * 2) = make_float2(s0r, s0i); *(float2*)(e + (32 + l31) * 2) = make_float2(s1r, s1i);
    }
}

__device__ __forceinline__ void s5_p2(MXL uchar* lds, const S5P& p) {
    const int tid = threadIdx.x, lane = tid & 63, wid = tid >> 6, hi = lane >> 5, l31 = lane & 31, fr = lane & 15, fq = lane >> 4;
    const int hi_r = (l31 >> 2) & 1, reg_r = (l31 & 3) + 4 * (l31 >> 3);
    const f32x16 zero = {0.f, 0.f, 0.f, 0.f, 0.f, 0.f, 0.f, 0.f, 0.f, 0.f, 0.f, 0.f, 0.f, 0.f, 0.f, 0.f};
    MXL uchar* SI = lds + wid * 8704;
    for (int unit = blockIdx.x; unit < 256; unit += gridDim.x) {
        const int g = (unit & 7) * 8 + wid, sp = unit >> 3, seg = 2 * sp + hi;
        bf16x8 bfr[4], cfr[4];
#pragma unroll
        for (int jt = 0; jt < 4; ++jt) bfr[jt] = *(const bf16x8*)(p.BB + ((size_t)(g * 128 + jt * 32 + l31)) * 16 + 8 * hi);
#pragma unroll
        for (int ks = 0; ks < 4; ++ks) cfr[ks] = *(const bf16x8*)(p.CC + ((size_t)(g * 16 + fr)) * 128 + ks * 32 + 8 * fq);
        const float a0r = p.AB[(g * 64 + l31) * 2], a0i = p.AB[(g * 64 + l31) * 2 + 1], a1r = p.AB[(g * 64 + 32 + l31) * 2], a1i = p.AB[(g * 64 + 32 + l31) * 2 + 1];
        float s0r = 0.f, s0i = 0.f, s1r = 0.f, s1i = 0.f;
        {
            const float p0r = p.A256[(g * 64 + l31) * 2], p0i = p.A256[(g * 64 + l31) * 2 + 1], p1r = p.A256[(g * 64 + 32 + l31) * 2], p1i = p.A256[(g * 64 + 32 + l31) * 2 + 1];
            for (int s = 0; s < seg; ++s) { const float* e = p.E + ((size_t)(s * 64 + g) * 64) * 2; const float2 e0 = *(const float2*)(e + l31 * 2), e1 = *(const float2*)(e + (32 + l31) * 2);
                const float n0r = p0r * s0r - p0i * s0i + e0.x, n0i = p0r * s0i + p0i * s0r + e0.y; s0r = n0r; s0i = n0i;
                const float n1r = p1r * s1r - p1i * s1i + e1.x, n1i = p1r * s1i + p1i * s1r + e1.y; s1r = n1r; s1i = n1i; }
        }
        const f32x4 dk = *(const f32x4*)(p.dsk + 16 * g + 4 * fq);
        const bf16_t* ub = p.U5 + ((size_t)(2 * sp + hi_r) * 256 + reg_r) * 1024 + 16 * g + 8 * hi;
        bf16x8 af = *(const bf16x8*)ub;
        for (int it = 0; it < 16; ++it) {
            const bf16x8 nx = *(const bf16x8*)(ub + (size_t)(it < 15 ? it + 1 : it) * 16384);
            const f32x16 c0 = __builtin_amdgcn_mfma_f32_32x32x16_bf16(af, bfr[0], zero, 0, 0, 0), c1 = __builtin_amdgcn_mfma_f32_32x32x16_bf16(af, bfr[1], zero, 0, 0, 0);
            const f32x16 c2 = __builtin_amdgcn_mfma_f32_32x32x16_bf16(af, bfr[2], zero, 0, 0, 0), c3 = __builtin_amdgcn_mfma_f32_32x32x16_bf16(af, bfr[3], zero, 0, 0, 0);
            MXL bf16_t* si = (MXL bf16_t*)SI + (16 * hi) * 136 + l31;
            S5_SCAN16(c0, c1, c2, c3, si[reg * 136] = (bf16_t)f2bf(s0r); si[reg * 136 + 32] = (bf16_t)f2bf(s1r); si[reg * 136 + 64] = (bf16_t)f2bf(s0i); si[reg * 136 + 96] = (bf16_t)f2bf(s1i); )
            asm volatile("s_waitcnt lgkmcnt(0)" ::: "memory");
#pragma unroll
            for (int tl = 0; tl < 2; ++tl) {
                f32x4 acc = {0.f, 0.f, 0.f, 0.f};
#pragma unroll
                for (int ks = 0; ks < 4; ++ks) acc = mma(cfr[ks], ldfrag(SI + (16 * tl + fr) * 272 + ks * 64 + fq * 16), acc);
                const size_t go = ((size_t)(2 * sp + tl) * 256 + 16 * it + fr) * 1024 + 16 * g + 4 * fq;
                const u32x2 uu = *(const u32x2*)(p.U5 + go);
                float y0 = acc[0] + dk[0] * bf2f(uu.x & 0xffffu), y1 = acc[1] + dk[1] * bf2f(uu.x >> 16), y2 = acc[2] + dk[2] * bf2f(uu.y & 0xffffu), y3 = acc[3] + dk[3] * bf2f(uu.y >> 16);
                u32x2 w; w.x = pk2(gelu_tanh_(y0), gelu_tanh_(y1)); w.y = pk2(gelu_tanh_(y2), gelu_tanh_(y3));
                *(u32x2*)(p.Y + go) = w;
            }
            asm volatile("s_waitcnt lgkmcnt(0)" ::: "memory");
            af = nx;
        }
    }
}
}
using pg8::bf16_t;
#define LAS __attribute__((address_space(3)))
__device__ __forceinline__ unsigned f2bf(float f) { unsigned u = __builtin_bit_cast(unsigned, f); return (u + 0x7fffu + ((u >> 16) & 1u)) >> 16; }
__device__ __forceinline__ unsigned pk2(float lo, float hi) { return f2bf(lo) | (f2bf(hi) << 16); }
typedef unsigned v4u __attribute__((ext_vector_type(4)));

template <class Epi>
__global__ void __launch_bounds__(512, 2) gemm_kernel(pg8::Gemm g, Epi E) {
    extern __shared__ __attribute__((aligned(16))) unsigned char lds[];
    pg8::StaticOrder S; S.init(g.M, g.N, (int)gridDim.x, (int)blockIdx.x);
    pg8::gemm_phase<Epi, pg8::StaticOrder, true, true>((LAS unsigned char*)lds, g, S, E);
}

__global__ void __launch_bounds__(256) wt_convert(const float* __restrict__ src, int K, int ldsrc, int nsrc, bf16_t* __restrict__ dst, int half) {
    __shared__ float tile[64][65];
    const int n0 = blockIdx.x * 64, k0 = blockIdx.y * 64, tid = threadIdx.x;
    for (int i = 0; i < 16; ++i) { const int e = tid + 256 * i, kk = e >> 6, nn = e & 63, n = n0 + nn;
        int col; bool ok;
        if (half == 0) { col = n; ok = n < nsrc; } else { const int t = n >> 8, w = n & 255; col = (w < 128 ? 0 : half) + t * 128 + (w & 127); ok = true; }
        tile[kk][nn] = ok ? src[(size_t)(k0 + kk) * ldsrc + col] : 0.f; }
    __syncthreads();
    const int nn = tid >> 2, kq = tid & 3;
    v4u o0, o1;
    o0.x = pk2(tile[kq * 16 + 0][nn], tile[kq * 16 + 1][nn]); o0.y = pk2(tile[kq * 16 + 2][nn], tile[kq * 16 + 3][nn]); o0.z = pk2(tile[kq * 16 + 4][nn], tile[kq * 16 + 5][nn]); o0.w = pk2(tile[kq * 16 + 6][nn], tile[kq * 16 + 7][nn]);
    o1.x = pk2(tile[kq * 16 + 8][nn], tile[kq * 16 + 9][nn]); o1.y = pk2(tile[kq * 16 + 10][nn], tile[kq * 16 + 11][nn]); o1.z = pk2(tile[kq * 16 + 12][nn], tile[kq * 16 + 13][nn]); o1.w = pk2(tile[kq * 16 + 14][nn], tile[kq * 16 + 15][nn]);
    v4u* d = (v4u*)(dst + (size_t)(n0 + nn) * K + k0 + kq * 16);
    d[0] = o0; d[1] = o1;
}
__global__ void __launch_bounds__(256) cvt_bf16(const float* __restrict__ src, bf16_t* __restrict__ dst) {
    const size_t i = ((size_t)blockIdx.x * 256 + threadIdx.x) * 8;
    const float4 a = *(const float4*)(src + i), b = *(const float4*)(src + i + 4);
    v4u o; o.x = pk2(a.x, a.y); o.y = pk2(a.z, a.w); o.z = pk2(b.x, b.y); o.w = pk2(b.z, b.w);
    *(v4u*)(dst + i) = o;
}

__global__ void __launch_bounds__(256) ln_res(const float* xin, const float* h, float* xout, const float* __restrict__ g, const float* __restrict__ b) {
    const int row = blockIdx.x * 4 + (threadIdx.x >> 6), lane = threadIdx.x & 63;
    float v[16]; float s = 0.f;
    for (int j = 0; j < 16; ++j) { const int c = lane + 64 * j; v[j] = ALPHA * xin[(size_t)row * D + c] + h[(size_t)row * D + c]; s += v[j]; }
    for (int o = 1; o < 64; o <<= 1) s += __shfl_xor(s, o);
    const float mean = s * (1.f / D); float q = 0.f;
    for (int j = 0; j < 16; ++j) { v[j] -= mean; q += v[j] * v[j]; }
    for (int o = 1; o < 64; o <<= 1) q += __shfl_xor(q, o);
    const float rstd = rsqrtf(q * (1.f / D) + LN_EPS);
    for (int j = 0; j < 16; ++j) { const int c = lane + 64 * j; xout[(size_t)row * D + c] = v[j] * rstd * g[c] + b[c]; }
}

__global__ void hgrn_lb_kernel(const float* __restrict__ logits, float* __restrict__ lb  ) {
    const int c = blockIdx.x * blockDim.x + threadIdx.x; if (c >= D) return;
    float l[4], mx = -1e30f; for (int i = 0; i < 4; ++i) { l[i] = logits[i * D + c]; mx = fmaxf(mx, l[i]); }
    float e[4], s = 0.f; for (int i = 0; i < 4; ++i) { e[i] = expf(l[i] - mx); s += e[i]; }
    float cs = 0.f, c0 = 0.f; for (int i = 0; i < 4; ++i) { cs += e[i] / s; if (i == 0) c0 = cs; lb[i * D + c] = cs - c0; }
}

__global__ void __launch_bounds__(128) hgrn_naive(const float* __restrict__ proj  , const float* __restrict__ lbv  , const float* __restrict__ norm_w  , float* __restrict__ mix  ) {
    __shared__ float sq[128], sf[128], sk[128], red[2];
    const int h = blockIdx.x, e = threadIdx.x, col = h * 128 + e;
    float S[128];
#pragma unroll
    for (int d = 0; d < 128; ++d) S[d] = 0.f;
    const float lb = lbv[col], nw = norm_w[e];
    for (int t = 0; t < L; ++t) {
        const float* pr = proj + (size_t)t * 4096;
        const float qr = pr[col], fr = pr[1024 + col], v = pr[2048 + col], gr = pr[3072 + col];
        const float sg = sigmoidf_(fr);
        const float ft = lb + (1.f - lb) * sg;
        const float kt = (1.f - lb) * sigmoidf_(-fr);
        sq[e] = siluf_(qr); sf[e] = ft; sk[e] = kt;
        __syncthreads();
        float o = 0.f;
#pragma unroll
        for (int d = 0; d < 128; ++d) { S[d] = sf[d] * S[d] + sk[d] * v; o += sq[d] * S[d]; }
        float ss = o * o;
        for (int off = 1; off < 64; off <<= 1) ss += __shfl_xor(ss, off);
        if ((e & 63) == 0) red[e >> 6] = ss;
        __syncthreads();
        const float tot = red[0] + red[1];
        mix[(size_t)t * D + col] = o * rsqrtf(tot * (1.f / 128.f) + HN_EPS) * nw * siluf_(gr);
        __syncthreads();
    }
}

__global__ void __launch_bounds__(128) mlstm_naive(const float* __restrict__ proj  , const float* __restrict__ conv_w  , const float* __restrict__ gate_b  ,
                                                   const float* __restrict__ norm_w  , float* __restrict__ mix) {
    __shared__ float sq[64], sk[64], red[2];
    const int h = blockIdx.x, e = threadIdx.x;
    constexpr int W = 3088;
    const int cch = e < 64 ? h * 64 + e : 512 + h * 64 + (e - 64);
    const float cw0 = conv_w[cch], cw1 = conv_w[1024 + cch], cw2 = conv_w[2048 + cch], cw3 = conv_w[3072 + cch];
    float p0 = 0.f, p1 = 0.f, p2 = 0.f;
    float C[64], n[64];
#pragma unroll
    for (int d = 0; d < 64; ++d) { C[d] = 0.f; n[d] = 0.f; }
    const float bi = gate_b[h], bf = gate_b[8 + h], nw = norm_w[h * 128 + e];
    for (int t = 0; t < L; ++t) {
        const float* pr = proj + (size_t)t * W;
        const float u = pr[cch];
        float cv = cw0 * p0 + cw1 * p1 + cw2 * p2 + cw3 * u; p0 = p1; p1 = p2; p2 = u;
        cv = siluf_(cv);
        if (e < 64) sq[e] = cv; else sk[e - 64] = cv * 0.125f;
        const float v = pr[1024 + h * 128 + e], op = pr[2048 + h * 128 + e];
        const float gi = pr[3072 + h] + bi, gf = pr[3080 + h] + bf;
        const float it = expf(gi), ft = sigmoidf_(gf);
        __syncthreads();
        float num = 0.f, den = 0.f;
#pragma unroll
        for (int d = 0; d < 64; ++d) { const float kk = it * sk[d]; C[d] = ft * C[d] + kk * v; n[d] = ft * n[d] + kk; num += sq[d] * C[d]; den += sq[d] * n[d]; }
        const float hh = num / fmaxf(fabsf(den), 1.f);
        float ss = hh * hh;
        for (int off = 1; off < 64; off <<= 1) ss += __shfl_xor(ss, off);
        if ((e & 63) == 0) red[e >> 6] = ss;
        __syncthreads();
        const float tot = red[0] + red[1];
        mix[(size_t)t * D + h * 128 + e] = hh * rsqrtf(tot * (1.f / 128.f) + HN_EPS) * nw * sigmoidf_(op);
        __syncthreads();
    }
}

__global__ void __launch_bounds__(64) s5_naive(const float* __restrict__ u  , const float* __restrict__ a_re, const float* __restrict__ a_im, const float* __restrict__ log_dt,
                                               const float* __restrict__ b_re, const float* __restrict__ b_im, const float* __restrict__ c_re, const float* __restrict__ c_im,
                                               const float* __restrict__ dsk, float* __restrict__ mix) {
    __shared__ float ssr[64], ssi[64];
    const int g = blockIdx.x, p = threadIdx.x;
    const float dt = expf(log_dt[g]);
    const float ar = a_re[g * 64 + p], ai = a_im[g * 64 + p];
    const float mag = expf(ar * dt);
    const float abr = mag * cosf(ai * dt), abi = mag * sinf(ai * dt);
    const float nr = abr - 1.f, ni = abi, den = ar * ar + ai * ai;
    const float cr = (nr * ar + ni * ai) / den, ci = (ni * ar - nr * ai) / den;
    float bbr[16], bbi[16];
    for (int c = 0; c < 16; ++c) { const float br = b_re[(g * 64 + p) * 16 + c], bim = b_im[(g * 64 + p) * 16 + c]; bbr[c] = cr * br - ci * bim; bbi[c] = cr * bim + ci * br; }
    const int oc = p & 15, oq = p >> 4;
    float ccr[16], cci[16];
    for (int j = 0; j < 16; ++j) { ccr[j] = c_re[(g * 16 + oc) * 64 + oq * 16 + j]; cci[j] = c_im[(g * 16 + oc) * 64 + oq * 16 + j]; }
    const float dk = dsk[g * 16 + oc];
    float sr = 0.f, si = 0.f;
    for (int t = 0; t < L; ++t) {
        const float* ur = u + (size_t)t * D + g * 16;
        float br = 0.f, bi = 0.f;
#pragma unroll
        for (int c = 0; c < 16; ++c) { const float uu = ur[c]; br += bbr[c] * uu; bi += bbi[c] * uu; }
        const float nsr = abr * sr - abi * si + br, nsi = abr * si + abi * sr + bi; sr = nsr; si = nsi;
        ssr[p] = sr; ssi[p] = si;
        __syncthreads();
        float y = 0.f;
#pragma unroll
        for (int j = 0; j < 16; ++j) y += ssr[oq * 16 + j] * ccr[j] - ssi[oq * 16 + j] * cci[j];
        y += __shfl_xor(y, 16); y += __shfl_xor(y, 32);
        if (oq == 0) { y += dk * ur[oc]; mix[(size_t)t * D + g * 16 + oc] = gelu_tanh_(y); }
        __syncthreads();
    }
}

__global__ void glu_kernel(const float* __restrict__ z, float* __restrict__ h) {
    const size_t i = (size_t)blockIdx.x * blockDim.x + threadIdx.x; const size_t m = i / D, c = i % D;
    h[i] = z[m * 2048 + c] * sigmoidf_(z[m * 2048 + 1024 + c]);
}


#define MXL __attribute__((address_space(3)))
constexpr int MIX_LDS = 122880;
template <int PH> __global__ void __launch_bounds__(512, 2) hgrn_kernel(mx::HgrnP p) {
    extern __shared__ __attribute__((aligned(16))) unsigned char lds[];
    if (PH == 0) mx::hgrn_p2a((MXL unsigned char*)lds, p); else if (PH == 1) mx::hgrn_p2b(p); else mx::hgrn_p2c((MXL unsigned char*)lds, p);
}
template <int PH> static void launch_hgrn(hipStream_t st, const mx::HgrnP& p) {
    static bool init = false;
    if (!init) { (void)hipFuncSetAttribute((const void*)hgrn_kernel<PH>, hipFuncAttributeMaxDynamicSharedMemorySize, MIX_LDS); init = true; }
    hipLaunchKernelGGL(hgrn_kernel<PH>, dim3(256), dim3(512), MIX_LDS, st, p);
}

template <int PH> __global__ void __launch_bounds__(512, 2) mlstm_kernel(mx::MlstmP p) {
    extern __shared__ __attribute__((aligned(16))) unsigned char lds[];
    if (PH == 0) mx::mlstm_p2a((MXL unsigned char*)lds, p); else if (PH == 1) mx::mlstm_p2b(p); else mx::mlstm_p2c((MXL unsigned char*)lds, p);
}
__global__ void __launch_bounds__(512, 2) mlstm_gates_kernel(const float* x, const float* w_in, const float* gate_b, float* GATES) {
    extern __shared__ __attribute__((aligned(16))) unsigned char lds[];
    mx::mlstm_gates((MXL unsigned char*)lds, x, w_in, gate_b, GATES);
}
template <int PH> static void launch_mlstm(hipStream_t st, const mx::MlstmP& p) {
    static bool init = false;
    if (!init) { (void)hipFuncSetAttribute((const void*)mlstm_kernel<PH>, hipFuncAttributeMaxDynamicSharedMemorySize, MIX_LDS); init = true; }
    hipLaunchKernelGGL(mlstm_kernel<PH>, dim3(256), dim3(512), MIX_LDS, st, p);
}

template <int PH> __global__ void __launch_bounds__(512, 2) s5_kernel(mx::S5P p) {
    extern __shared__ __attribute__((aligned(16))) unsigned char lds[];
    if (PH == 0) mx::s5_p1(p); else mx::s5_p2((MXL unsigned char*)lds, p);
}
__global__ void __launch_bounds__(512, 2) s5_tables_kernel(const float* a_re, const float* a_im, const float* log_dt, const float* b_re, const float* b_im, const float* c_re, const float* c_im,
                                                           float* AB, float* A256, bf16_t* BB, bf16_t* CC) {
    mx::s5_tables(a_re, a_im, log_dt, b_re, b_im, c_re, c_im, AB, A256, BB, CC);
}
template <int PH> static void launch_s5(hipStream_t st, const mx::S5P& p) {
    static bool init = false;
    if (!init) { (void)hipFuncSetAttribute((const void*)s5_kernel<PH>, hipFuncAttributeMaxDynamicSharedMemorySize, MIX_LDS); init = true; }
    hipLaunchKernelGGL(s5_kernel<PH>, dim3(256), dim3(512), MIX_LDS, st, p);
}

constexpr int GEMM_LDS = 131072;
template <class Epi> static void launch_gemm(hipStream_t st, const bf16_t* A, const bf16_t* Bt, int M, int N, int K, Epi E) {
    static bool init = false;
    if (!init) { (void)hipFuncSetAttribute((const void*)gemm_kernel<Epi>, hipFuncAttributeMaxDynamicSharedMemorySize, GEMM_LDS); init = true; }
    pg8::Gemm g{A, Bt, M, N, K, 0};
    hipLaunchKernelGGL(gemm_kernel<Epi>, dim3(256), dim3(512), GEMM_LDS, st, g, E);
}
static void convert_w(hipStream_t st, const float* src, int K, int ldsrc, int nsrc, int Npad, bf16_t* dst, int half) {
    wt_convert<<<dim3(Npad / 64, K / 64), 256, 0, st>>>(src, K, ldsrc, nsrc, dst, half);
}

extern "C" void kernel_launch(void* const* d_in, const int* in_sizes, int n_in, void* d_out, int out_size, void* d_ws, size_t ws_size, hipStream_t stream) {
    const float* x = (const float*)d_in[0];
    const float* hgrn_w_in = (const float*)d_in[1]; const float* hgrn_norm_w = (const float*)d_in[2]; const float* hgrn_w_out = (const float*)d_in[3]; const float* hgrn_lb_logits = (const float*)d_in[4];
    const float* mlstm_w_in = (const float*)d_in[5]; const float* mlstm_conv_w = (const float*)d_in[6]; const float* mlstm_gate_b = (const float*)d_in[7]; const float* mlstm_norm_w = (const float*)d_in[8]; const float* mlstm_w_out = (const float*)d_in[9];
    const float* s5_w_in = (const float*)d_in[10]; const float* s5_a_re = (const float*)d_in[11]; const float* s5_a_im = (const float*)d_in[12]; const float* s5_log_dt = (const float*)d_in[13];
    const float* s5_b_re = (const float*)d_in[14]; const float* s5_b_im = (const float*)d_in[15]; const float* s5_c_re = (const float*)d_in[16]; const float* s5_c_im = (const float*)d_in[17];
    const float* s5_d = (const float*)d_in[18]; const float* s5_w_out = (const float*)d_in[19];
    const float* ffn_w_gate_up = (const float*)d_in[20]; const float* ffn_w_down = (const float*)d_in[21]; const float* ln_g = (const float*)d_in[22]; const float* ln_b = (const float*)d_in[23];
    float* out = (float*)d_out;
    char* ws = (char*)d_ws;
    const size_t MiB = 1u << 20;
    if (ws_size < 344 * MiB) { fprintf(stderr, "ws too small: %zu\n", ws_size); return; }
    bf16_t* WB = (bf16_t*)(ws);
    float* proj = (float*)(ws + 16 * MiB);
    float* mix = (float*)(ws + 272 * MiB);
    bf16_t* A1 = (bf16_t*)(ws + 276 * MiB);
    bf16_t* A2 = (bf16_t*)(ws + 80 * MiB);
    float* hbuf = (float*)(ws + 16 * MiB);
    float* zbuf = (float*)(ws + 112 * MiB);
    float* hbuf5 = (float*)(ws + 16 * MiB);
    bf16_t* Hff = (bf16_t*)(ws + 112 * MiB);
    float* dn = (float*)(ws + 200 * MiB);
    float* lb = (float*)(ws + 340 * MiB);

    hgrn_lb_kernel<<<4, 256, 0, stream>>>(hgrn_lb_logits, lb);
    const float* xc = x;
    for (int i = 0; i < 4; ++i) {
        const int kind = i % 3, j = i / 3;
        cvt_bf16<<<L * D / 2048, 256, 0, stream>>>(xc, A1);
        float* hb = hbuf;
        if (kind == 0) {
            convert_w(stream, hgrn_w_in + (size_t)j * D * 4096, D, 4096, 4096, 4096, WB, 0);
            bf16_t* Qb = (bf16_t*)(ws + 16 * MiB); float* LFb = (float*)(ws + 48 * MiB); bf16_t* Vb = (bf16_t*)(ws + 112 * MiB); bf16_t* Gb = (bf16_t*)(ws + 144 * MiB);
            bf16_t* STb = (bf16_t*)(ws + 176 * MiB); float* DECb = (float*)(ws + 240 * MiB); bf16_t* Ob = (bf16_t*)(ws + 244 * MiB);
            pg8::EpiSplit E{}; E.dst[0] = Qb; E.dst[1] = LFb; E.dst[2] = Vb; E.dst[3] = Gb; E.act[0] = 1; E.act[1] = 3; E.act[2] = 0; E.act[3] = 1; E.lb = lb + i * D;
            launch_gemm(stream, A1, WB, L, 4096, D, E);
            mx::HgrnP hp{Qb, LFb, Vb, Gb, STb, DECb, Ob, hgrn_norm_w + j * 128};
            launch_hgrn<0>(stream, hp); launch_hgrn<1>(stream, hp); launch_hgrn<2>(stream, hp);
            convert_w(stream, hgrn_w_out + (size_t)j * D * D, D, D, D, D, WB, 0);
            launch_gemm(stream, Ob, WB, L, D, D, pg8::EpiF32N{hbuf, D, D});
        } else if (kind == 1) {
            convert_w(stream, mlstm_w_in, D, 3088, 3088, 3072, WB, 0);
            bf16_t* QKb = (bf16_t*)(ws + 16 * MiB); bf16_t* Vb = (bf16_t*)(ws + 48 * MiB); bf16_t* OGb = (bf16_t*)(ws + 80 * MiB); float* GAb = (float*)(ws + 112 * MiB);
            bf16_t* CTb = (bf16_t*)(ws + 116 * MiB); float* NLb = (float*)(ws + 148 * MiB); float* NPb = (float*)(ws + 149 * MiB); float* BLb = (float*)(ws + 150 * MiB); float* MLb = BLb + 4096; float* MPb = BLb + 8192;
            bf16_t* Ob = (bf16_t*)(ws + 244 * MiB);
            { static bool init = false; if (!init) { (void)hipFuncSetAttribute((const void*)mlstm_gates_kernel, hipFuncAttributeMaxDynamicSharedMemorySize, MIX_LDS); init = true; } }
            hipLaunchKernelGGL(mlstm_gates_kernel, dim3(256), dim3(512), MIX_LDS, stream, xc, mlstm_w_in, mlstm_gate_b, GAb);
            pg8::EpiSplit E{}; E.dst[0] = QKb; E.dst[1] = Vb; E.dst[2] = OGb; E.dst[3] = OGb; E.act[0] = 0; E.act[1] = 0; E.act[2] = 2; E.act[3] = 2; E.lb = lb;
            launch_gemm(stream, A1, WB, L, 3072, D, E);
            mx::MlstmP mp{QKb, Vb, OGb, GAb, CTb, NLb, NPb, BLb, MLb, MPb, Ob, mlstm_conv_w, mlstm_norm_w};
            launch_mlstm<0>(stream, mp); launch_mlstm<1>(stream, mp); launch_mlstm<2>(stream, mp);
            convert_w(stream, mlstm_w_out, D, D, D, D, WB, 0);
            launch_gemm(stream, Ob, WB, L, D, D, pg8::EpiF32N{hbuf, D, D});
        } else {
            convert_w(stream, s5_w_in, D, D, D, D, WB, 0);
            bf16_t* U5b = (bf16_t*)(ws + 16 * MiB); bf16_t* Yb = (bf16_t*)(ws + 48 * MiB);
            float* ABb = (float*)(ws + 300 * MiB); float* A256b = ABb + 8192; bf16_t* BBb = (bf16_t*)(ws + 301 * MiB); bf16_t* CCb = BBb + 131072; float* Eb = (float*)(ws + 302 * MiB);
            pg8::EpiSplit E{}; E.dst[0] = U5b; E.dst[1] = U5b; E.dst[2] = U5b; E.dst[3] = U5b; E.lb = lb;
            launch_gemm(stream, A1, WB, L, D, D, E);
            hipLaunchKernelGGL(s5_tables_kernel, dim3(8), dim3(512), 0, stream, s5_a_re, s5_a_im, s5_log_dt, s5_b_re, s5_b_im, s5_c_re, s5_c_im, ABb, A256b, BBb, CCb);
            mx::S5P sp{U5b, Yb, ABb, A256b, BBb, CCb, Eb, s5_d};
            launch_s5<0>(stream, sp); launch_s5<1>(stream, sp);
            convert_w(stream, s5_w_out, D, 2048, 2048, 2048, WB, 0);
            launch_gemm(stream, Yb, WB, L, 2048, D, pg8::EpiF32N{zbuf, 2048, 2048});
            glu_kernel<<<(L * D) / 256, 256, 0, stream>>>(zbuf, hbuf5);
            hb = hbuf5;
        }
        ln_res<<<L / 4, 256, 0, stream>>>(xc, hb, out, ln_g + (i * 2 + 0) * D, ln_b + (i * 2 + 0) * D);
        xc = out;
        cvt_bf16<<<L * D / 2048, 256, 0, stream>>>(xc, A2);
        convert_w(stream, ffn_w_gate_up + (size_t)i * D * 2 * FF, D, 2 * FF, 2 * FF, 2 * FF, WB, FF);
        launch_gemm(stream, A2, WB, L, 2 * FF, D, pg8::EpiGateUp{Hff, FF, 0});
        convert_w(stream, ffn_w_down + (size_t)i * FF * D, FF, D, D, D, WB, 0);
        launch_gemm(stream, Hff, WB, L, D, FF, pg8::EpiF32N{dn, D, D});
        ln_res<<<L / 4, 256, 0, stream>>>(xc, dn, out, ln_g + (i * 2 + 1) * D, ln_b + (i * 2 + 1) * D);
    }
}
```
